# Optimizing an MI355X kernel written in HIP

```python
import jax, jax.numpy as jnp
from jax import lax
import numpy as np

D_MODEL = 2048
BATCH = 4
SEQ = 4096
DEPTH = 1

CHUNK = 64
SWA_Q_HEADS = 16
SWA_KV_HEADS = 4
SWA_HEAD_DIM = 64
SWA_GROUP = SWA_Q_HEADS // SWA_KV_HEADS
WINDOW = 128
WINDOW_CHUNKS = WINDOW // CHUNK
BAND = (WINDOW_CHUNKS + 1) * CHUNK
SWA_Q_W = SWA_Q_HEADS * SWA_HEAD_DIM
SWA_KV_W = SWA_KV_HEADS * SWA_HEAD_DIM
GDN_HEADS = 8
GDN_HEAD_DIM = 128
GDN_W = GDN_HEADS * GDN_HEAD_DIM
CONV_WIDTH = 4
IN_SIZES = (SWA_Q_W, SWA_KV_W, SWA_KV_W, GDN_W, GDN_W, GDN_W, GDN_W,
            GDN_HEADS, GDN_HEADS, D_MODEL, D_MODEL)
IN_WIDTH = sum(IN_SIZES)
N_GROUPS = 4
EXPERTS_PER_GROUP = 8
N_EXPERTS = N_GROUPS * EXPERTS_PER_GROUP
TOP_K = 2
EXPERT_FF = 512
DEEPNORM_ALPHA = (2 * DEPTH) ** 0.25
DEEPNORM_BETA = (8 * DEPTH) ** -0.25
LN_EPS = 1e-5
RMS_EPS = 1e-6
NEG_INF = -1e30

kernel_name = 'hybrid_swa_gdn_hier_moe_deepnorm_adaln'


def layer_norm(x, g=None, b=None):
    xf = x.astype(jnp.float32)
    mu = jnp.mean(xf, axis=-1, keepdims=True)
    var = jnp.mean(jnp.square(xf - mu), axis=-1, keepdims=True)
    y = (xf - mu) * lax.rsqrt(var + LN_EPS)
    if g is not None:
        y = y * g.astype(jnp.float32) + b.astype(jnp.float32)
    return y.astype(x.dtype)


def l2_normalize(x):
    return x * lax.rsqrt(jnp.sum(jnp.square(x), axis=-1, keepdims=True) + RMS_EPS)


def causal_depthwise_conv(x, w):
    s = x.shape[1]
    xp = jnp.pad(x, ((0, 0), (CONV_WIDTH - 1, 0), (0, 0)))
    y = xp[:, 0:s] * w[0]
    for i in range(1, CONV_WIDTH):
        y = y + xp[:, i:i + s] * w[i]
    return y


def swa_sink_attention(q, k, v, sinks):
    bsz, s, _ = q.shape
    n_c = s // CHUNK
    qf = q.astype(jnp.float32).reshape(bsz, n_c, CHUNK, SWA_KV_HEADS, SWA_GROUP, SWA_HEAD_DIM)
    pad = WINDOW_CHUNKS * CHUNK

    def band(t):
        t = t.astype(jnp.float32).reshape(bsz, s, SWA_KV_HEADS, SWA_HEAD_DIM)
        tp = jnp.pad(t, ((0, 0), (pad, 0), (0, 0), (0, 0)))
        tp = tp.reshape(bsz, n_c + WINDOW_CHUNKS, CHUNK, SWA_KV_HEADS, SWA_HEAD_DIM)
        return jnp.concatenate([tp[:, j:j + n_c] for j in range(WINDOW_CHUNKS + 1)], axis=2)

    kb = band(k)
    vb = band(v)
    key_chunk = jnp.arange(n_c)[:, None] - WINDOW_CHUNKS + (jnp.arange(BAND) // CHUNK)[None, :]
    valid = key_chunk >= 0
    scores = jnp.einsum('bnqhgd,bnkhd->bnhgqk', qf, kb) * (SWA_HEAD_DIM ** -0.5)
    scores = jnp.where(valid[None, :, None, None, None, :], scores, NEG_INF)
    sink = sinks.astype(jnp.float32).reshape(1, 1, SWA_KV_HEADS, SWA_GROUP, 1, 1)
    sink = jnp.broadcast_to(sink, scores.shape[:-1] + (1,))
    probs = jax.nn.softmax(jnp.concatenate([scores, sink], axis=-1), axis=-1)[..., :-1]
    out = jnp.einsum('bnhgqk,bnkhd->bnqhgd', probs, vb)
    return out.reshape(bsz, s, SWA_Q_W).astype(v.dtype)


def gated_delta_rule(q, k, v, g, beta):
    bsz, s, h, dk = q.shape
    dv = v.shape[-1]
    n_c = s // CHUNK

    def to_chunks(t):
        return t.reshape(bsz, n_c, CHUNK, h, -1).transpose(0, 3, 1, 2, 4)

    q, k, v = to_chunks(q), to_chunks(k), to_chunks(v)
    g = g.reshape(bsz, n_c, CHUNK, h).transpose(0, 3, 1, 2)
    beta = beta.reshape(bsz, n_c, CHUNK, h).transpose(0, 3, 1, 2)
    cum = jnp.cumsum(g, axis=-1)
    idx = jnp.arange(CHUNK)
    strict = idx[:, None] > idx[None, :]
    incl = idx[:, None] >= idx[None, :]
    diff = cum[..., :, None] - cum[..., None, :]
    decay_incl = jnp.where(incl, jnp.exp(jnp.where(incl, diff, 0.0)), 0.0)
    kk = jnp.einsum('bhncd,bhnjd->bhncj', k, k)
    a_mat = jnp.where(strict, beta[..., :, None] * kk * decay_incl, 0.0)
    eye = jnp.eye(CHUNK, dtype=jnp.float32)
    t_mat = lax.linalg.triangular_solve(a_mat + eye, jnp.broadcast_to(eye, a_mat.shape),
                                        left_side=True, lower=True, unit_diagonal=True)
    u = t_mat @ (v * beta[..., None])
    w = t_mat @ (k * (beta * jnp.exp(cum))[..., None])
    qk = jnp.einsum('bhncd,bhnjd->bhncj', q, k) * decay_incl
    q_dec = q * jnp.exp(cum)[..., None]
    k_dec = k * jnp.exp(cum[..., -1:] - cum)[..., None]
    chunk_decay = jnp.exp(cum[..., -1])

    def step(state, xs):
        u_c, w_c, qk_c, qd_c, kd_c, dec_c = xs
        v_new = u_c - w_c @ state
        o_c = qd_c @ state + qk_c @ v_new
        state = dec_c[..., None, None] * state + jnp.swapaxes(kd_c, -1, -2) @ v_new
        return state, o_c

    xs = (jnp.moveaxis(u, 2, 0), jnp.moveaxis(w, 2, 0), jnp.moveaxis(qk, 2, 0),
          jnp.moveaxis(q_dec, 2, 0), jnp.moveaxis(k_dec, 2, 0), jnp.moveaxis(chunk_decay, 2, 0))
    state0 = jnp.zeros((bsz, h, dk, dv), jnp.float32)
    _, o = lax.scan(step, state0, xs)
    return o.transpose(1, 0, 3, 2, 4).reshape(bsz, s, h, dv)


def token_mixer(u, w_in, conv_w, swa_sinks, gdn_a_log, gdn_dt_bias, gdn_norm_w,
                w_proj_a, w_proj_b, w_out):
    bsz, s, _ = u.shape
    hcat = u @ w_in
    split_points = tuple(np.cumsum(IN_SIZES)[:-1].tolist())
    qa, ka, va, qb, kb, vb, zb, b_logit, a_logit, ga_logit, gb_logit = jnp.split(hcat, split_points, axis=-1)
    oa = swa_sink_attention(qa, ka, va, swa_sinks)
    qkv = jax.nn.silu(causal_depthwise_conv(jnp.concatenate([qb, kb, vb], axis=-1), conv_w))
    qb, kb, vb = jnp.split(qkv, 3, axis=-1)
    shp = (bsz, s, GDN_HEADS, GDN_HEAD_DIM)
    qh = l2_normalize(qb.astype(jnp.float32).reshape(shp)) * (GDN_HEAD_DIM ** -0.5)
    kh = l2_normalize(kb.astype(jnp.float32).reshape(shp))
    vh = vb.astype(jnp.float32).reshape(shp)
    beta = jax.nn.sigmoid(b_logit.astype(jnp.float32))
    g = -jnp.exp(gdn_a_log.astype(jnp.float32)) * jax.nn.softplus(
        a_logit.astype(jnp.float32) + gdn_dt_bias.astype(jnp.float32))
    ob = gated_delta_rule(qh, kh, vh, g, beta)
    ob = ob * lax.rsqrt(jnp.mean(jnp.square(ob), axis=-1, keepdims=True) + RMS_EPS)
    ob = ob * gdn_norm_w.astype(jnp.float32) * jax.nn.silu(zb.astype(jnp.float32).reshape(shp))
    ob = ob.reshape(bsz, s, GDN_W).astype(u.dtype)
    merged = jax.nn.sigmoid(ga_logit) * (oa @ w_proj_a) + jax.nn.sigmoid(gb_logit) * (ob @ w_proj_b)
    return merged @ w_out


def hier_moe(u, w_router_group, b_router_group, w_router_expert, b_router_expert, w_gate_up, w_down):
    bsz, s, d = u.shape
    t = u.reshape(-1, d)
    n = t.shape[0]
    p_group = jax.nn.softmax((t @ w_router_group + b_router_group).astype(jnp.float32), axis=-1)
    g_idx = jnp.argmax(p_group, axis=-1)
    p_group_sel = jnp.take_along_axis(p_group, g_idx[:, None], axis=-1)
    e_logits = (t @ w_router_expert + b_router_expert).astype(jnp.float32)
    e_logits = e_logits.reshape(n, N_GROUPS, EXPERTS_PER_GROUP)
    e_logits = jnp.take_along_axis(e_logits, g_idx[:, None, None], axis=1)[:, 0]
    p_exp = jax.nn.softmax(e_logits, axis=-1)
    top_p, top_i = lax.top_k(p_exp, TOP_K)
    top_p = top_p / jnp.sum(top_p, axis=-1, keepdims=True)
    weights = p_group_sel * top_p
    expert_idx = g_idx[:, None] * EXPERTS_PER_GROUP + top_i
    combine = jnp.sum(jax.nn.one_hot(expert_idx, N_EXPERTS, dtype=jnp.float32) * weights[..., None], axis=1)
    y = jnp.zeros((n, d), jnp.float32)
    for e in range(N_EXPERTS):
        gate, up = jnp.split(t @ w_gate_up[e], 2, axis=-1)
        y = y + combine[:, e:e + 1] * ((jax.nn.silu(gate) * up) @ w_down[e]).astype(jnp.float32)
    return y.reshape(bsz, s, d).astype(u.dtype)


def setup_inputs(seed: int = 0) -> dict:
    key = jax.random.key(seed)
    ks = jax.random.split(key, 24)
    f32 = jnp.float32
    nrm = lambda k, shape, scale: jax.random.normal(k, shape, f32) * scale
    L = DEPTH
    dt = jnp.exp(jax.random.uniform(ks[7], (L, GDN_HEADS), f32, np.log(1e-3), np.log(1e-1)))
    return {
        'x': nrm(ks[0], (BATCH, SEQ, D_MODEL), 1.0),
        'c': nrm(ks[1], (BATCH, D_MODEL), 1.0),
        'w_ada': nrm(ks[2], (L, D_MODEL, 6 * D_MODEL), 0.5 * D_MODEL ** -0.5),
        'b_ada': nrm(ks[3], (L, 6 * D_MODEL), 0.02),
        'w_in': nrm(ks[4], (L, D_MODEL, IN_WIDTH), D_MODEL ** -0.5),
        'conv_w': nrm(ks[5], (L, CONV_WIDTH, 3 * GDN_W), CONV_WIDTH ** -0.5),
        'swa_sinks': nrm(ks[6], (L, SWA_Q_HEADS), 0.5),
        'gdn_a_log': jnp.log(jax.random.uniform(ks[8], (L, GDN_HEADS), f32, 1.0, 16.0)),
        'gdn_dt_bias': dt + jnp.log(-jnp.expm1(-dt)),
        'gdn_norm_w': 1.0 + nrm(ks[9], (L, GDN_HEAD_DIM), 0.1),
        'w_proj_a': nrm(ks[10], (L, SWA_Q_W, D_MODEL), DEEPNORM_BETA * SWA_Q_W ** -0.5),
        'w_proj_b': nrm(ks[11], (L, GDN_W, D_MODEL), DEEPNORM_BETA * GDN_W ** -0.5),
        'w_out': nrm(ks[12], (L, D_MODEL, D_MODEL), DEEPNORM_BETA * D_MODEL ** -0.5),
        'ln1_g': 1.0 + nrm(ks[13], (L, D_MODEL), 0.1),
        'ln1_b': nrm(ks[14], (L, D_MODEL), 0.02),
        'w_router_group': nrm(ks[15], (L, D_MODEL, N_GROUPS), D_MODEL ** -0.5),
        'b_router_group': nrm(ks[16], (L, N_GROUPS), 0.01),
        'w_router_expert': nrm(ks[17], (L, D_MODEL, N_EXPERTS), D_MODEL ** -0.5),
        'b_router_expert': nrm(ks[18], (L, N_EXPERTS), 0.01),
        'w_gate_up': nrm(ks[19], (L, N_EXPERTS, D_MODEL, 2 * EXPERT_FF), D_MODEL ** -0.5),
        'w_down': nrm(ks[20], (L, N_EXPERTS, EXPERT_FF, D_MODEL), DEEPNORM_BETA * EXPERT_FF ** -0.5),
        'ln2_g': 1.0 + nrm(ks[21], (L, D_MODEL), 0.1),
        'ln2_b': nrm(ks[22], (L, D_MODEL), 0.02),
    }


def reference(x, c, w_ada, b_ada, w_in, conv_w, swa_sinks, gdn_a_log, gdn_dt_bias, gdn_norm_w,
              w_proj_a, w_proj_b, w_out, ln1_g, ln1_b, w_router_group, b_router_group,
              w_router_expert, b_router_expert, w_gate_up, w_down, ln2_g, ln2_b):
    for l in range(DEPTH):
        mod = (jax.nn.silu(c) @ w_ada[l] + b_ada[l])[:, None, :]
        sh1, sc1, g1, sh2, sc2, g2 = jnp.split(mod, 6, axis=-1)
        u = layer_norm(x) * (1.0 + sc1) + sh1
        mix = token_mixer(u, w_in[l], conv_w[l], swa_sinks[l], gdn_a_log[l], gdn_dt_bias[l],
                          gdn_norm_w[l], w_proj_a[l], w_proj_b[l], w_out[l])
        x = layer_norm(DEEPNORM_ALPHA * x + g1 * mix, ln1_g[l], ln1_b[l])
        u = layer_norm(x) * (1.0 + sc2) + sh2
        ffn = hier_moe(u, w_router_group[l], b_router_group[l], w_router_expert[l],
                       b_router_expert[l], w_gate_up[l], w_down[l])
        x = layer_norm(DEEPNORM_ALPHA * x + g2 * ffn, ln2_g[l], ln2_b[l])
    return x
```

```cpp
#include <hip/hip_runtime.h>
#include <cstdio>
#include <cstdint>

#define LAS __attribute__((address_space(3)))
typedef unsigned short bf16;
typedef short bf16x8 __attribute__((ext_vector_type(8)));
typedef float f32x4 __attribute__((ext_vector_type(4)));
typedef float f32x2 __attribute__((ext_vector_type(2)));
typedef float f32x16 __attribute__((ext_vector_type(16)));
typedef unsigned u32x4 __attribute__((ext_vector_type(4)));
typedef unsigned u32x2 __attribute__((ext_vector_type(2)));
typedef int i32x4 __attribute__((ext_vector_type(4)));
typedef __bf16 bf16x2_t __attribute__((ext_vector_type(2)));
typedef int i32x8 __attribute__((ext_vector_type(8)));

constexpr int NWAVES = 8, NTHREADS = 512;
constexpr int D = 2048, BATCH = 4, SEQ = 4096, MTOK = BATCH * SEQ;
constexpr int NEXP = 32, EFF = 512;
constexpr int IN_W = 9744, HC_W = 9728;
constexpr float LN_EPS = 1e-5f;
constexpr float ALPHA = 1.189207115002721f;
constexpr int MOE_ROWS = 40960;

constexpr size_t MiB = 1u << 20;
constexpr size_t WS_CTL = 0, CTL_ZERO_BYTES = 1 * MiB;
constexpr size_t WS_MODP = 1 * MiB;
constexpr size_t WS_MOD = 2 * MiB;
constexpr size_t WS_WBD = 2 * MiB + 256 * 1024;
constexpr size_t WS_WRH = 2 * MiB + 512 * 1024;
constexpr size_t WS_WRL = 2 * MiB + 768 * 1024;
constexpr size_t WS_RI = 3 * MiB;
constexpr size_t WS_RW = 3 * MiB + 512 * 1024;
constexpr size_t WS_TOKLIST = 4 * MiB;
constexpr size_t WS_BG = 6 * MiB;
constexpr size_t WS_WIN = 8 * MiB;
constexpr size_t WS_WP = 46 * MiB;
constexpr size_t WS_WOUT = 54 * MiB;
constexpr size_t WS_WGU = 62 * MiB;
constexpr size_t WS_WD = 190 * MiB;
constexpr size_t WS_U = 254 * MiB;
constexpr size_t WS_OAOB = 318 * MiB;
constexpr size_t WS_MERGED = 382 * MiB;
constexpr size_t WS_GDN = 446 * MiB;
constexpr size_t WS_HCAT = 590 * MiB;
constexpr size_t WS_H = WS_HCAT;
constexpr size_t WS_Y = WS_HCAT + 40 * MiB;
constexpr size_t WS_ULO = WS_HCAT + 200 * MiB;
constexpr size_t WS_END = 894 * MiB;
constexpr int CW_BAR = 4096;
constexpr int CW_CNT = 8192;

constexpr int SCRATCH_BYTES = 157696;
constexpr int LDSCTL_OFF = SCRATCH_BYTES;
constexpr int LDS_BYTES = SCRATCH_BYTES + 1024;

#define LDS_WAIT() asm volatile("s_waitcnt lgkmcnt(0)" ::: "memory")
#define VM_WAIT() asm volatile("s_waitcnt vmcnt(0)" ::: "memory")

__device__ __forceinline__ unsigned pk2(float lo, float hi) { bf16x2_t v; v.x = (__bf16)lo; v.y = (__bf16)hi; return __builtin_bit_cast(unsigned, v); }
__device__ __forceinline__ unsigned pk_fp8x4(float a, float b, float c, float d) { int w = 0; w = __builtin_amdgcn_cvt_pk_fp8_f32(a, b, w, false); w = __builtin_amdgcn_cvt_pk_fp8_f32(c, d, w, true); return (unsigned)w; }
__device__ __forceinline__ float bf2f(unsigned short b) { return __uint_as_float(((unsigned)b) << 16); }
__device__ __forceinline__ float bflo(unsigned w) { return __uint_as_float(w << 16); }
__device__ __forceinline__ float bfhi(unsigned w) { return __uint_as_float(w & 0xffff0000u); }
__device__ __forceinline__ float sigmoidf_(float x) { return __builtin_amdgcn_rcpf(1.f + __expf(-x)); }
__device__ __forceinline__ float siluf_(float x) { return x * __builtin_amdgcn_rcpf(1.f + __expf(-x)); }

__device__ __forceinline__ int hw_lane() { int l; asm volatile("v_mbcnt_lo_u32_b32 %0, -1, 0\n\tv_mbcnt_hi_u32_b32 %0, -1, %0" : "=v"(l)); return l; }
#define XB_TMO      128
#define XB_XCNT(j)  (256  + 64 * (j))
#define XB_XSUB(j)  (1280 + 64 * (j))
#define XB_XGEN(j)  (2304 + 64 * (j))
#define XB_TOP      3328
#define XB_TOPGEN   3392
#define XCD_BAR_WORDS 3456
#define XB_SPIN_CAP (1u << 18)

__device__ __forceinline__ unsigned xb_ld(unsigned* p)              { return __hip_atomic_load(p, __ATOMIC_RELAXED, __HIP_MEMORY_SCOPE_AGENT); }
__device__ __forceinline__ unsigned xb_add(unsigned* p, unsigned v) { return __hip_atomic_fetch_add(p, v, __ATOMIC_RELAXED, __HIP_MEMORY_SCOPE_AGENT); }
__device__ __forceinline__ unsigned xb_xcc_id() { return (unsigned)__builtin_amdgcn_s_getreg((3 << 11) | 20) & 0xFu; }
#define XB_SPIN(cond, bar) do { unsigned _sp = 0; while (cond) { __builtin_amdgcn_s_sleep(1); \
    if ((++_sp & 255u) == 0u) { if (xb_ld(&(bar)[XB_TMO])) break; if (_sp > XB_SPIN_CAP) { atomicAdd(&(bar)[XB_TMO], 1u); break; } } } } while (0)

struct XcdBarrier { unsigned* bar; unsigned x; volatile LAS unsigned* st; bool wave0; };

__device__ __forceinline__ XcdBarrier xcd_barrier_post(unsigned* bar, volatile LAS unsigned* st, bool wave0) {
    XcdBarrier b; b.bar = bar; b.x = xb_xcc_id(); b.st = st; b.wave0 = wave0;
    if (wave0 && hw_lane() == 0) (void)xb_add(&bar[XB_XCNT(b.x)], 1u);
    return b;
}
__device__ __forceinline__ void xcd_barrier_complete(unsigned* bar, unsigned x, unsigned& nloc, unsigned& nx) {
    const unsigned G = gridDim.x * gridDim.y * gridDim.z;
    unsigned sum, cnt, mine, sp = 0u;
    for (;;) {
        sum = 0u; cnt = 0u; mine = 0u;
#pragma unroll
        for (unsigned j = 0; j < 16; ++j) { const unsigned c = xb_ld(&bar[XB_XCNT(j)]); sum += c; cnt += (c > 0u) ? 1u : 0u; mine = (j == x) ? c : mine; }
        if (sum == G) break;
        __builtin_amdgcn_s_sleep(1);
        if ((++sp & 255u) == 0u) { if (xb_ld(&bar[XB_TMO])) break; if (sp > XB_SPIN_CAP) { atomicAdd(&bar[XB_TMO], 1u); break; } }
    }
    nloc = mine > 0u ? mine : 1u; nx = cnt > 0u ? cnt : 1u;
}
__device__ __forceinline__ void xcd_barrier(const XcdBarrier& b) {
    asm volatile("s_waitcnt vmcnt(0)" ::: "memory");
    __syncthreads();
    if (b.wave0 && hw_lane() == 0) {
        unsigned* bar = b.bar;
        __builtin_amdgcn_s_waitcnt(0);
        unsigned nloc = b.st[0], nx = b.st[1];
        if (nloc == 0u) { xcd_barrier_complete(bar, b.x, nloc, nx); b.st[0] = nloc; b.st[1] = nx; }
        const unsigned old = xb_add(&bar[XB_XSUB(b.x)], 1u);
        const unsigned gen = old / nloc;
        if (old + 1u == (gen + 1u) * nloc) {
            __builtin_amdgcn_fence(__ATOMIC_RELEASE, "agent");
            asm volatile("s_waitcnt vmcnt(0)" ::: "memory");
            const unsigned og = xb_add(&bar[XB_TOP], 1u);
            const unsigned tg = og / nx;
            if (og + 1u == (tg + 1u) * nx) xb_add(&bar[XB_TOPGEN], 1u);
            else XB_SPIN(xb_ld(&bar[XB_TOPGEN]) == tg, bar);
            __builtin_amdgcn_fence(__ATOMIC_ACQUIRE, "agent");
            xb_add(&bar[XB_XGEN(b.x)], 1u);
            asm volatile("s_waitcnt vmcnt(0)" ::: "memory");
        } else {
            XB_SPIN(xb_ld(&bar[XB_XGEN(b.x)]) == gen, bar);
            __builtin_amdgcn_fence(__ATOMIC_ACQUIRE, "agent");
            asm volatile("s_waitcnt vmcnt(0)" ::: "memory");
        }
    }
    __syncthreads();
}

namespace pg8 {
constexpr int BM = 256, BK = 64, HALF = 128, HTB = HALF * BK * 2, STAGE_BYTES = 8 * HTB, NXCD = 8, WGM = 2;
__host__ __device__ __forceinline__ int lds_byte(int r, int c) { const int st = (r >> 4) * 2 + (c >> 5), rr = r & 15, cc = c & 31, ob = rr * 64 + cc * 2; return st * 1024 + (ob ^ (((ob >> 9) & 1) << 5)); }
__host__ __device__ __forceinline__ void stage_rc(int b, int& R, int& C) { const int st = b / 1024, sb = b % 1024, swz = sb ^ (((sb >> 9) & 1) << 5); R = (st >> 1) * 16 + swz / 64; C = (st & 1) * 32 + (swz % 64) / 2; }
__host__ __device__ __forceinline__ int perm32(int rho) { const int n = rho >> 4, i = rho & 15; return 8 * (i >> 2) + 4 * n + (i & 3); }

struct Unit { int pm, pn, e, r0, nrows; };

struct StaticOrder {
    const char* A; const char* Bt; int K;
    int nM, nN, nwg, G, c, wgm;
    __device__ void init(const void* A_, const void* Bt_, int M, int N, int K_, int G_, int c_, int wgm_ = WGM) { A = (const char*)A_; Bt = (const char*)Bt_; K = K_; nM = M / BM; nN = N / BM; nwg = nM * nN; G = G_; c = c_; wgm = wgm_; }
    __device__ bool next(int i, Unit& u) const {
        const long L = (long)i * G + c; if (L >= nwg) return false;
        int wgid = (int)L; { const int q = nwg / NXCD, r = nwg % NXCD, xcd = wgid % NXCD, off = wgid / NXCD; wgid = (xcd < r ? xcd * (q + 1) : r * (q + 1) + (xcd - r) * q) + off; }
        const int nig = wgm * nN, gid = wgid / nig, fm = gid * wgm, gsz = (nM - fm) < wgm ? (nM - fm) : wgm;
        u.pm = fm + ((wgid % nig) % gsz); u.pn = (wgid % nig) / gsz; u.e = 0; u.r0 = 0; u.nrows = BM; return true;
    }
    __device__ __forceinline__ const char* a_base(const Unit& u) const { return A + (size_t)u.pm * (size_t)BM * K * 2; }
    __device__ __forceinline__ const char* b_base(const Unit& u) const { return Bt + (size_t)u.pn * (size_t)BM * K * 2; }
    __device__ __forceinline__ void a_rows(const Unit&, int, LAS unsigned*) const {}
};

struct MoeOrder {
    const char* A; const char* Bt; int K; size_t b_estride;
    const int* toklist; const volatile LAS int* tb; int ncol, G, c;
    __device__ bool next(int i, Unit& u) const {
        const int L0 = i * G + c, total = __builtin_amdgcn_readfirstlane(tb[32]) * ncol; if (L0 >= total) return false;
        int L; { const int q = total / NXCD, r = total % NXCD, xcd = L0 % NXCD, off = L0 / NXCD; L = (xcd < r ? xcd * (q + 1) : r * (q + 1) + (xcd - r) * q) + off; }
        const int rt = L / ncol; u.pn = L - rt * ncol; u.pm = rt;
        int e = 0;
        for (int j = 1; j < 32; ++j) e = (tb[j] <= rt) ? j : e;
        u.e = e; u.r0 = (rt - tb[e]) * BM; const int left = tb[33 + e] - u.r0; u.nrows = left < BM ? left : BM;
        u.pm = __builtin_amdgcn_readfirstlane(u.pm); u.pn = __builtin_amdgcn_readfirstlane(u.pn); u.e = __builtin_amdgcn_readfirstlane(u.e); u.r0 = __builtin_amdgcn_readfirstlane(u.r0); u.nrows = __builtin_amdgcn_readfirstlane(u.nrows);
        return true;
    }
    __device__ __forceinline__ const char* a_base(const Unit& u) const { return toklist ? A : A + (size_t)u.pm * (size_t)BM * K * 2; }
    __device__ __forceinline__ const char* b_base(const Unit& u) const { return Bt + (size_t)u.e * b_estride + (size_t)u.pn * (size_t)BM * K * 2; }
    __device__ __forceinline__ void a_rows(const Unit& u, int tid, LAS unsigned* dst) const {
#pragma unroll
        for (int h = 0; h < 2; ++h)
#pragma unroll
            for (int i = 0; i < 2; ++i) { int R, C; stage_rc(tid * 16 + i * 8192, R, C); int r = h * HALF + R; r = r < u.nrows ? r : u.nrows - 1;
                const int tok = toklist[(size_t)u.e * MTOK + u.r0 + r]; dst[(h * 2 + i) * 512] = ((unsigned)tok * (unsigned)K + (unsigned)C) * 2u; }
    }
};

__device__ __forceinline__ void glds16(const char* sbase, unsigned voff, unsigned lds_dst) {
    unsigned keep;
    asm volatile("s_mov_b32 %0, m0\n\ts_mov_b32 m0, %3\n\ts_nop 0\n\tglobal_load_lds_dwordx4 %1, %2\n\ts_mov_b32 m0, %0" : "=&s"(keep) : "v"(voff), "s"(sbase), "s"(lds_dst) : "memory");
}
__device__ __forceinline__ const char* uniform_ptr(const char* p) { const unsigned long long v = (unsigned long long)p; const unsigned lo = __builtin_amdgcn_readfirstlane((unsigned)v), hi = __builtin_amdgcn_readfirstlane((unsigned)(v >> 32)); return (const char*)(((unsigned long long)hi << 32) | lo); }
template <class Epi, class Sched, bool GATHER, bool MIDK, bool FP8 = false>
__device__ __forceinline__ void gemm_phase(LAS unsigned char* lds, const Sched& S, const Epi& E, int wid) {
    int lane = hw_lane(); asm volatile("" : "+v"(lane));
    const int tid = wid * 64 + lane, wr = wid >> 2, wc = wid & 3, fr = lane & 15, fq = lane >> 4;
    const int K = S.K, nt = K / BK;
    unsigned voffA[2], voffB[2];
#pragma unroll
    for (int i = 0; i < 2; ++i) { int R, C; stage_rc(tid * 16 + i * 8192, R, C); const int Rb = Epi::PERM ? ((R & ~31) + perm32(R & 31)) : R;
        voffA[i] = (unsigned)(R * K + C) * 2u; voffB[i] = (unsigned)(Rb * K + C) * 2u; }
    const size_t kstep = (size_t)(BK * 2);
    const size_t hstep = (size_t)HALF * K * 2;
    const unsigned ldsw = (unsigned)wid * 1024u;
    const int aoff = lds_byte(wr * 64 + fr, fq * 8), boff = lds_byte(wc * 32 + fr, fq * 8);
    LAS unsigned* gofs = (LAS unsigned*)(lds + STAGE_BYTES) + tid;
    int par = 0;
#define PG8_SA(b, h) (((b) * 2 + (h)) * HTB)
#define PG8_SB(b, h) ((4 + (b) * 2 + (h)) * HTB)
    const unsigned ldsbase = (unsigned)(unsigned long long)lds + ldsw;
#define PG8_STAGE(bufoff, gbase, voff) do { const char* _gb = uniform_ptr((const char*)(gbase)); _Pragma("unroll") for (int _i = 0; _i < 2; ++_i) glds16(_gb, (voff)[_i], ldsbase + (bufoff) + _i * 8192); } while (0)
#define PG8_STAGE_A(bufoff, kbase, h, nx) do { if constexpr (GATHER) { const char* _gb = uniform_ptr((const char*)(kbase)); _Pragma("unroll") for (int _i = 0; _i < 2; ++_i) { const unsigned _o = gofs[((((nx) ? par ^ 1 : par) * 4) + (h) * 2 + _i) * 512]; \
        glds16(_gb, _o, ldsbase + (bufoff) + _i * 8192); } } \
        else { PG8_STAGE(bufoff, (const char*)(kbase) + ((h) ? hstep : (size_t)0), voffA); } } while (0)
    const LAS unsigned char* ldsA = lds + aoff; const LAS unsigned char* ldsB = lds + 4 * HTB + boff;
#define PG8_LD8(ptr, imm) __builtin_shufflevector(*(const LAS i32x4*)((ptr) + (imm)), *(const LAS i32x4*)((ptr) + (imm) + 1024), 0, 1, 2, 3, 4, 5, 6, 7)
#define PG8_LDA(dst, b, h) do { _Pragma("unroll") for (int m = 0; m < 4; ++m) dst[m] = PG8_LD8(ldsA, ((b) * 2 + (h)) * HTB + m * 2048); } while (0)
#define PG8_LDB(dst, b, h) do { _Pragma("unroll") for (int n = 0; n < 2; ++n) dst[n] = PG8_LD8(ldsB, ((b) * 2 + (h)) * HTB + n * 2048); } while (0)
#define PG8_LO(v) __builtin_bit_cast(bf16x8, __builtin_shufflevector(v, v, 0, 1, 2, 3))
#define PG8_HI(v) __builtin_bit_cast(bf16x8, __builtin_shufflevector(v, v, 4, 5, 6, 7))
#define PG8_MMA(ai, bj, At, Bt) do { __builtin_amdgcn_s_setprio(1); if constexpr (FP8) { _Pragma("unroll") for (int m = 0; m < 4; ++m) _Pragma("unroll") for (int n = 0; n < 2; ++n) \
        acc[ai][bj][m][n] = __builtin_amdgcn_mfma_scale_f32_16x16x128_f8f6f4(Bt[n], At[m], acc[ai][bj][m][n], 0, 0, 0, 0x7f7f7f7f, 0, 0x7f7f7f7f); } \
        else { _Pragma("unroll") for (int m = 0; m < 4; ++m) _Pragma("unroll") for (int n = 0; n < 2; ++n) { \
        acc[ai][bj][m][n] = __builtin_amdgcn_mfma_f32_16x16x32_bf16(PG8_LO(Bt[n]), PG8_LO(At[m]), acc[ai][bj][m][n], 0, 0, 0); \
        acc[ai][bj][m][n] = __builtin_amdgcn_mfma_f32_16x16x32_bf16(PG8_HI(Bt[n]), PG8_HI(At[m]), acc[ai][bj][m][n], 0, 0, 0); } } __builtin_amdgcn_s_setprio(0); } while (0)
#define PG8_WAIT_V(n) asm volatile("s_waitcnt vmcnt(" #n ")" ::: "memory")
#define PG8_WAIT_L(n) asm volatile("s_waitcnt lgkmcnt(" #n ")" ::: "memory")
#define PG8_BAR __builtin_amdgcn_s_barrier()
#define PG8_SCHED __builtin_amdgcn_sched_barrier(0)
    Unit cur, nxt; int ui = 0;
    if (!S.next(0, cur)) return;
    f32x4 acc[2][2][4][2];
#pragma unroll
    for (int a = 0; a < 2; ++a)
#pragma unroll
        for (int b = 0; b < 2; ++b)
#pragma unroll
            for (int m = 0; m < 4; ++m)
#pragma unroll
                for (int n = 0; n < 2; ++n) acc[a][b][m][n] = (f32x4){0.f, 0.f, 0.f, 0.f};
    i32x8 At[4], B0[2], B1[2];
    const char* cA = S.a_base(cur); const char* cB = S.b_base(cur);
    if constexpr (GATHER) S.a_rows(cur, tid, gofs);
    PG8_STAGE(PG8_SB(0, 0), cB, voffB); PG8_STAGE(PG8_SB(0, 1), cB + hstep, voffB); PG8_STAGE_A(PG8_SA(0, 0), cA, 0, false); PG8_STAGE_A(PG8_SA(0, 1), cA, 1, false);
    if (wr == 1) PG8_BAR;
    PG8_WAIT_V(2); PG8_BAR;
    PG8_STAGE(PG8_SB(1, 0), cB + kstep, voffB); PG8_STAGE_A(PG8_SA(1, 0), cA + kstep, 0, false); PG8_STAGE(PG8_SB(1, 1), cB + hstep + kstep, voffB);
    PG8_WAIT_V(6); PG8_BAR;
    for (;;) {
        const bool has_next = S.next(ui + 1, nxt);
        const char* nA = has_next ? S.a_base(nxt) : cA; const char* nB = has_next ? S.b_base(nxt) : cB;
        if constexpr (GATHER) S.a_rows(has_next ? nxt : cur, tid, gofs + (par ^ 1) * 4 * 512);
        for (int tb0 = 0; tb0 < nt; tb0 += (MIDK ? nt / 2 : nt)) {
        if constexpr (MIDK) { if (tb0 != 0) E.mid(acc, cur, wr, wc, fr, fq); }
        const int tend = tb0 + (MIDK ? nt / 2 : nt);
        for (int t = tb0; t < tend; t += 2) {
            const bool last = (t == nt - 2);
            const char* a1 = cA + (size_t)(t + 1) * kstep;
            const char* a2 = last ? nA : cA + (size_t)(t + 2) * kstep; const char* b2 = last ? nB : cB + (size_t)(t + 2) * kstep;
            const char* a3 = a2 + kstep; const char* b3 = b2 + kstep;
            PG8_LDB(B0, 0, 0); PG8_LDB(B1, 0, 1); PG8_SCHED; PG8_LDA(At, 0, 0); PG8_STAGE_A(PG8_SA(1, 1), a1, 1, false);
            PG8_WAIT_V(8); PG8_WAIT_L(0); PG8_BAR; PG8_MMA(0, 0, At, B0); PG8_MMA(0, 1, At, B1); PG8_BAR; PG8_SCHED;
            PG8_LDA(At, 0, 1); PG8_STAGE(PG8_SB(0, 0), b2, voffB); PG8_STAGE(PG8_SB(0, 1), b2 + hstep, voffB); PG8_STAGE_A(PG8_SA(0, 0), a2, 0, last);
            PG8_WAIT_V(8); PG8_WAIT_L(0); PG8_BAR; PG8_MMA(1, 0, At, B0); PG8_MMA(1, 1, At, B1); PG8_BAR; PG8_SCHED;
            PG8_LDB(B0, 1, 0); PG8_LDB(B1, 1, 1); PG8_SCHED; PG8_LDA(At, 1, 0); PG8_STAGE_A(PG8_SA(0, 1), a2, 1, last);
            PG8_WAIT_V(8); PG8_WAIT_L(0); PG8_BAR; PG8_MMA(0, 0, At, B0); PG8_MMA(0, 1, At, B1); PG8_BAR; PG8_SCHED;
            PG8_LDA(At, 1, 1); PG8_STAGE(PG8_SB(1, 0), b3, voffB); PG8_STAGE(PG8_SB(1, 1), b3 + hstep, voffB); PG8_STAGE_A(PG8_SA(1, 0), a3, 0, last);
            PG8_WAIT_V(8); PG8_WAIT_L(0); PG8_BAR; PG8_MMA(1, 0, At, B0); PG8_MMA(1, 1, At, B1); PG8_BAR; PG8_SCHED;
        }
        }
        if (wr == 0) PG8_BAR;
        E(acc, cur, wr, wc, fr, fq);
        if (!has_next) break;
#pragma unroll
        for (int a = 0; a < 2; ++a)
#pragma unroll
            for (int b = 0; b < 2; ++b)
#pragma unroll
                for (int m = 0; m < 4; ++m)
#pragma unroll
                    for (int n = 0; n < 2; ++n) acc[a][b][m][n] = (f32x4){0.f, 0.f, 0.f, 0.f};
        cur = nxt; cA = nA; cB = nB; ++ui;
        if constexpr (GATHER) par ^= 1;
        if (wr == 1) PG8_BAR;
    }
    PG8_WAIT_V(0);
    PG8_BAR;
#undef PG8_SA
#undef PG8_SB
#undef PG8_STAGE
#undef PG8_STAGE_A
#undef PG8_LDA
#undef PG8_LDB
#undef PG8_MMA
#undef PG8_LD8
#undef PG8_LO
#undef PG8_HI
#undef PG8_WAIT_V
#undef PG8_WAIT_L
#undef PG8_BAR
#undef PG8_SCHED
}

struct EpiGateUp {
    static constexpr bool PERM = true;
    bf16* H; float sc;
    __device__ __forceinline__ void operator()(const f32x4 (&acc)[2][2][4][2], const Unit& u, int wr, int wc, int, int) const {
        const int hl = hw_lane(); int frq = hl & 15; asm volatile("" : "+v"(frq)); int fqq = hl >> 4; asm volatile("" : "+v"(fqq));
        const int row0 = u.pm * BM + wr * 64 + frq, col0 = u.pn * HALF + wc * 32 + 8 * fqq;
#pragma unroll
        for (int ai = 0; ai < 2; ++ai)
#pragma unroll
            for (int m = 0; m < 4; ++m) {
                unsigned char* rowp = (unsigned char*)H + (size_t)(row0 + ai * HALF + m * 16) * EFF + col0;
                const f32x4 g0 = acc[ai][0][m][0] * sc, g1 = acc[ai][0][m][1] * sc, u0 = acc[ai][1][m][0] * (8.f * sc), u1 = acc[ai][1][m][1] * (8.f * sc);
#define EGU_C(x) fminf(fmaxf((x), -440.f), 440.f)
                u32x2 w;
                w.x = pk_fp8x4(EGU_C(siluf_(g0[0]) * u0[0]), EGU_C(siluf_(g0[1]) * u0[1]), EGU_C(siluf_(g0[2]) * u0[2]), EGU_C(siluf_(g0[3]) * u0[3]));
                w.y = pk_fp8x4(EGU_C(siluf_(g1[0]) * u1[0]), EGU_C(siluf_(g1[1]) * u1[1]), EGU_C(siluf_(g1[2]) * u1[2]), EGU_C(siluf_(g1[3]) * u1[3]));
#undef EGU_C
                *(u32x2*)rowp = w;
            }
    }
};
struct EpiBf16 {
    static constexpr bool PERM = true;
    unsigned char* O; int ldc; float sc;
    __device__ __forceinline__ void operator()(const f32x4 (&acc)[2][2][4][2], const Unit& u, int wr, int wc, int fr, int fq) const {
        int frq = fr; asm volatile("" : "+v"(frq)); int fqq = fq; asm volatile("" : "+v"(fqq));
        const int row0 = u.pm * BM + wr * 64 + frq, col0 = u.pn * BM + wc * 32 + 8 * fqq;
#define EY_C(x) fminf(fmaxf((x) * sc, -440.f), 440.f)
#pragma unroll
        for (int ai = 0; ai < 2; ++ai)
#pragma unroll
            for (int m = 0; m < 4; ++m) {
                unsigned char* rowp = O + (size_t)(row0 + ai * HALF + m * 16) * ldc + col0;
#pragma unroll
                for (int bj = 0; bj < 2; ++bj) { const f32x4 v0 = acc[ai][bj][m][0], v1 = acc[ai][bj][m][1];
                    u32x2 w; w.x = pk_fp8x4(EY_C(v0[0]), EY_C(v0[1]), EY_C(v0[2]), EY_C(v0[3])); w.y = pk_fp8x4(EY_C(v1[0]), EY_C(v1[1]), EY_C(v1[2]), EY_C(v1[3]));
                    *(u32x2*)(rowp + bj * HALF) = w; }
            }
#undef EY_C
    }
};

struct EpiHcat {
    static constexpr bool PERM = true;
    bf16* O; float sc;
    __device__ __forceinline__ void operator()(const f32x4 (&acc)[2][2][4][2], const Unit& u, int wr, int wc, int, int) const {
        const int hl = hw_lane(); int frq = hl & 15; asm volatile("" : "+v"(frq)); int fqq = hl >> 4; asm volatile("" : "+v"(fqq));
        const int row0 = u.pm * BM + wr * 64 + frq;
        const int kind = u.pn < 4 ? 0 : (u.pn < 18 ? 1 : (u.pn < 22 ? 2 : 3));
        if (kind == 3) {
            const int c0 = 128 * (u.pn - 22) + wc * 32 + 8 * fqq;
#pragma unroll
            for (int ai = 0; ai < 2; ++ai)
#pragma unroll
                for (int m = 0; m < 4; ++m) {
                    bf16* rowp = O + (size_t)(row0 + ai * HALF + m * 16) * HC_W + 5632 + c0;
                    float rho[8], sb[8];
#pragma unroll
                    for (int n = 0; n < 2; ++n)
#pragma unroll
                        for (int j = 0; j < 4; ++j) { const float pa = 1.f + __expf(fminf(-acc[ai][0][m][n][j] * sc, 40.f)), pb = 1.f + __expf(fminf(-acc[ai][1][m][n][j] * sc, 40.f));
                            const float r = __builtin_amdgcn_rcpf(pa * pb);
                            sb[4 * n + j] = r * pa; rho[4 * n + j] = (pb * pb) * r; }
                    u32x4 w; w.x = pk2(rho[0], rho[1]); w.y = pk2(rho[2], rho[3]); w.z = pk2(rho[4], rho[5]); w.w = pk2(rho[6], rho[7]);
                    *(u32x4*)rowp = w;
                    w.x = pk2(sb[0], sb[1]); w.y = pk2(sb[2], sb[3]); w.z = pk2(sb[4], sb[5]); w.w = pk2(sb[6], sb[7]);
                    *(u32x4*)(rowp + 2048) = w;
                }
            return;
        }
        const int col0 = u.pn * BM + wc * 32 + 8 * fqq;
#pragma unroll
        for (int ai = 0; ai < 2; ++ai)
#pragma unroll
            for (int m = 0; m < 4; ++m) {
                bf16* rowp = O + (size_t)(row0 + ai * HALF + m * 16) * HC_W + col0;
#pragma unroll
                for (int bj = 0; bj < 2; ++bj) { f32x4 v0 = acc[ai][bj][m][0] * sc, v1 = acc[ai][bj][m][1] * sc;
                    if (kind == 0) { v0 = v0 * 0.125f; v1 = v1 * 0.125f; }
                    else if (kind == 2) {
#pragma unroll
                        for (int j = 0; j < 4; ++j) { v0[j] = siluf_(v0[j]); v1[j] = siluf_(v1[j]); } }
                    u32x4 w; w.x = pk2(v0[0], v0[1]); w.y = pk2(v0[2], v0[3]); w.z = pk2(v1[0], v1[1]); w.w = pk2(v1[2], v1[3]);
                    *(u32x4*)(rowp + bj * HALF) = w; }
            }
    }
};
struct EpiMerged {
    static constexpr bool PERM = true;
    const bf16* HC; bf16* O;
    __device__ __forceinline__ void mid(f32x4 (&acc)[2][2][4][2], const Unit& u, int wr, int wc, int fr, int fq) const {
        int frq = fr; asm volatile("" : "+v"(frq)); int fqq = fq; asm volatile("" : "+v"(fqq));
        const int row0 = u.pm * BM + wr * 64 + frq, col0 = u.pn * BM + wc * 32 + 8 * fqq;
#pragma unroll
        for (int ai = 0; ai < 2; ++ai) {
            u32x4 rh[4][2];
#pragma unroll
            for (int m = 0; m < 4; ++m)
#pragma unroll
                for (int bj = 0; bj < 2; ++bj) rh[m][bj] = *(const u32x4*)(HC + (size_t)(row0 + ai * HALF + m * 16) * HC_W + col0 + bj * HALF + 5632);
#pragma unroll
            for (int m = 0; m < 4; ++m)
#pragma unroll
                for (int bj = 0; bj < 2; ++bj) { const u32x4 a4 = rh[m][bj];
                    const f32x4 r0 = {bflo(a4.x), bfhi(a4.x), bflo(a4.y), bfhi(a4.y)}, r1 = {bflo(a4.z), bfhi(a4.z), bflo(a4.w), bfhi(a4.w)};
                    acc[ai][bj][m][0] = acc[ai][bj][m][0] * r0; acc[ai][bj][m][1] = acc[ai][bj][m][1] * r1; }
            asm volatile("" : "+v"(acc[ai][0][0][0]), "+v"(acc[ai][1][3][1]) :: "memory");
        }
    }
    __device__ __forceinline__ void operator()(const f32x4 (&acc)[2][2][4][2], const Unit& u, int wr, int wc, int fr, int fq) const {
        int frq = fr; asm volatile("" : "+v"(frq)); int fqq = fq; asm volatile("" : "+v"(fqq));
        const int row0 = u.pm * BM + wr * 64 + frq, col0 = u.pn * BM + wc * 32 + 8 * fqq;
#pragma unroll
        for (int ai = 0; ai < 2; ++ai) {
            u32x4 sb[4][2];
#pragma unroll
            for (int m = 0; m < 4; ++m)
#pragma unroll
                for (int bj = 0; bj < 2; ++bj) sb[m][bj] = *(const u32x4*)(HC + (size_t)(row0 + ai * HALF + m * 16) * HC_W + col0 + 7680 + bj * HALF);
#pragma unroll
            for (int m = 0; m < 4; ++m)
#pragma unroll
                for (int bj = 0; bj < 2; ++bj) { const u32x4 b4 = sb[m][bj];
                    const f32x4 v0 = acc[ai][bj][m][0], v1 = acc[ai][bj][m][1];
                    u32x2 w;
                    w.x = pk_fp8x4(0.125f * v0[0] * fmaxf(bflo(b4.x), 1e-20f), 0.125f * v0[1] * fmaxf(bfhi(b4.x), 1e-20f), 0.125f * v0[2] * fmaxf(bflo(b4.y), 1e-20f), 0.125f * v0[3] * fmaxf(bfhi(b4.y), 1e-20f));
                    w.y = pk_fp8x4(0.125f * v1[0] * fmaxf(bflo(b4.z), 1e-20f), 0.125f * v1[1] * fmaxf(bfhi(b4.z), 1e-20f), 0.125f * v1[2] * fmaxf(bflo(b4.w), 1e-20f), 0.125f * v1[3] * fmaxf(bfhi(b4.w), 1e-20f));
                    *(u32x2*)((unsigned char*)O + (size_t)(row0 + ai * HALF + m * 16) * D + col0 + bj * HALF) = w; }
            asm volatile("" ::: "memory");
        }
    }
};
struct EpiMixG {
    static constexpr bool PERM = true;
    const float* MODv; bf16* O; float sc;
    __device__ __forceinline__ void operator()(const f32x4 (&acc)[2][2][4][2], const Unit& u, int wr, int wc, int fr, int fq) const {
        int frq = fr; asm volatile("" : "+v"(frq)); int fqq = fq; asm volatile("" : "+v"(fqq));
        const int row0 = u.pm * BM + wr * 64 + frq, col0 = u.pn * BM + wc * 32 + 8 * fqq;
        const float* g1 = MODv + (size_t)((u.pm * BM) / SEQ) * 6 * D + 2 * D;
        f32x4 gv[2][2];
#pragma unroll
        for (int bj = 0; bj < 2; ++bj)
#pragma unroll
            for (int n = 0; n < 2; ++n) gv[bj][n] = *(const f32x4*)(g1 + col0 + bj * HALF + 4 * n) * sc;
#pragma unroll
        for (int ai = 0; ai < 2; ++ai)
#pragma unroll
            for (int m = 0; m < 4; ++m) {
                bf16* rowp = O + (size_t)(row0 + ai * HALF + m * 16) * D + col0;
#pragma unroll
                for (int bj = 0; bj < 2; ++bj) { const f32x4 v0 = acc[ai][bj][m][0] * gv[bj][0], v1 = acc[ai][bj][m][1] * gv[bj][1];
                    u32x4 w; w.x = pk2(v0[0], v0[1]); w.y = pk2(v0[2], v0[3]); w.z = pk2(v1[0], v1[1]); w.w = pk2(v1[2], v1[3]);
                    *(u32x4*)(rowp + bj * HALF) = w; }
            }
    }
};
}

__device__ __forceinline__ float shx(float v, int o, int lane) { return __int_as_float(__builtin_amdgcn_ds_bpermute((lane ^ o) << 2, __float_as_int(v))); }
__device__ __forceinline__ float shl_(float v, int src_lane) { return __int_as_float(__builtin_amdgcn_ds_bpermute(src_lane << 2, __float_as_int(v))); }
__device__ __forceinline__ float wave_sum(float v, int lane) {
#pragma unroll
    for (int o = 1; o < 64; o <<= 1) v += shx(v, o, lane);
    return v;
}

struct Args { const float* in[23]; float* out; unsigned char* ws; };
enum { I_X = 0, I_C, I_WADA, I_BADA, I_WIN, I_CONVW, I_SINKS, I_ALOG, I_DTB, I_NORMW, I_WPA, I_WPB, I_WOUT, I_LN1G, I_LN1B, I_WRG, I_BRG, I_WRE, I_BRE, I_WGU, I_WDN, I_LN2G, I_LN2B };

__device__ __forceinline__ void ln_norm(f32x4 (&v)[8], int lane) {
    float s = 0.f;
#pragma unroll
    for (int j = 0; j < 8; ++j) s += (v[j].x + v[j].y) + (v[j].z + v[j].w);
    const float mean = wave_sum(s, lane) * (1.f / D);
    float s2 = 0.f;
#pragma unroll
    for (int j = 0; j < 8; ++j) { v[j] = v[j] - mean; s2 += (v[j].x * v[j].x + v[j].y * v[j].y) + (v[j].z * v[j].z + v[j].w * v[j].w); }
    const float rstd = 1.f / sqrtf(wave_sum(s2, lane) * (1.f / D) + LN_EPS);
#pragma unroll
    for (int j = 0; j < 8; ++j) v[j] = v[j] * rstd;
}

struct TDesc { const float* src; bf16* dst; int ldsrc, lddst; float f8scale; };
__device__ __forceinline__ void t_load(const TDesc& d, int lane, f32x4 (&v)[8]) {
#pragma unroll
    for (int i = 0; i < 8; ++i) v[i] = __builtin_nontemporal_load((const f32x4*)(d.src + (size_t)(8 * i + (lane >> 3)) * d.ldsrc + 4 * (lane & 7)));
}
__device__ __forceinline__ void t_store(const TDesc& d, const f32x4 (&v)[8], LAS float* scr, int lane) {
#pragma unroll
    for (int i = 0; i < 8; ++i) { LAS float* q = scr + (8 * i + (lane >> 3)) * 33 + 4 * (lane & 7); q[0] = v[i][0]; q[1] = v[i][1]; q[2] = v[i][2]; q[3] = v[i][3]; }
    LDS_WAIT(); asm volatile("" ::: "memory");
    const int c = lane & 7;
#pragma unroll
    for (int j = 0; j < 4; ++j) { const int n = (lane >> 3) + 8 * j; const LAS float* sp = scr + (8 * c) * 33 + n;
        if (d.f8scale != 0.f) { const float f = d.f8scale; u32x2 o8; o8.x = pk_fp8x4(sp[0 * 33] * f, sp[1 * 33] * f, sp[2 * 33] * f, sp[3 * 33] * f); o8.y = pk_fp8x4(sp[4 * 33] * f, sp[5 * 33] * f, sp[6 * 33] * f, sp[7 * 33] * f);
            __builtin_nontemporal_store(o8, (u32x2*)((unsigned char*)d.dst + (size_t)n * d.lddst + 8 * c)); }
        else { u32x4 o; o.x = pk2(sp[0 * 33], sp[1 * 33]); o.y = pk2(sp[2 * 33], sp[3 * 33]); o.z = pk2(sp[4 * 33], sp[5 * 33]); o.w = pk2(sp[6 * 33], sp[7 * 33]);
            __builtin_nontemporal_store(o, (u32x4*)(d.dst + (size_t)n * d.lddst + 8 * c)); } }
    LDS_WAIT(); asm volatile("" ::: "memory");
}
constexpr int TI_IN = 32 * 304, TI_PA = 16 * 64, TI_PB = 16 * 64, TI_OUT = 32 * 64, TI_P0 = TI_IN + TI_PA + TI_PB + TI_OUT;
__device__ __forceinline__ TDesc p0_desc(int r, const float* win, const float* wpa, const float* wpb, const float* wout, bf16* WIN, bf16* WP, bf16* WOUT) {
    TDesc d; d.f8scale = 0.f;
    if (r < TI_IN) { const int kb = r / 304, nb = r - kb * 304, nd = 32 * nb; int ns = nd;
        if (nd >= 5632) { const int g = nd - 5632, t = g >> 8, j = g & 255; ns = (j < 128 ? 5648 : 7696 - 128) + 128 * t + j; }
        d.src = win + (size_t)(64 * kb) * IN_W + ns; d.ldsrc = IN_W; d.dst = (bf16*)((unsigned char*)WIN + (size_t)nd * D + 64 * kb); d.lddst = D; d.f8scale = 64.f; return d; }
    r -= TI_IN;
    if (r < TI_PA) { const int kb = r >> 6, nb = r & 63; d.src = wpa + (size_t)(64 * kb) * D + 32 * nb; d.ldsrc = D; d.dst = (bf16*)((unsigned char*)WP + (size_t)(32 * nb) * D + 64 * kb); d.lddst = D; d.f8scale = 64.f; return d; }
    r -= TI_PA;
    if (r < TI_PB) { const int kb = r >> 6, nb = r & 63; d.src = wpb + (size_t)(64 * kb) * D + 32 * nb; d.ldsrc = D; d.dst = (bf16*)((unsigned char*)WP + (size_t)(32 * nb) * D + 1024 + 64 * kb); d.lddst = D; d.f8scale = 64.f; return d; }
    r -= TI_PB;
    { const int kb = r >> 6, nb = r & 63; d.src = wout + (size_t)(64 * kb) * D + 32 * nb; d.ldsrc = D; d.dst = (bf16*)((unsigned char*)WOUT + (size_t)(32 * nb) * D + 64 * kb); d.lddst = D; d.f8scale = 64.f; return d; }
}
constexpr int TI_GU = 32 * 32 * 32, TI_DN = 32 * 8 * 64, TI_MOE = TI_GU + TI_DN;
__device__ __forceinline__ TDesc moe_desc(int r, const float* wgu, const float* wdn, bf16* WGU, bf16* WD) {
    TDesc d; d.f8scale = 0.f;
    if (r < TI_GU) { const int e = r >> 10, rr = r & 1023, kb = rr >> 5, nb = rr & 31, nd = 32 * nb, pn = nd >> 8, j0 = nd & 255;
        const int ns = j0 < 128 ? 128 * pn + j0 : 512 + 128 * pn + (j0 - 128);
        d.src = wgu + (size_t)e * D * 1024 + (size_t)(64 * kb) * 1024 + ns; d.ldsrc = 1024; d.dst = (bf16*)((unsigned char*)WGU + (size_t)e * 1024 * D + (size_t)nd * D + 64 * kb); d.lddst = D; d.f8scale = 64.f; return d; }
    r -= TI_GU;
    { const int e = r >> 9, rr = r & 511, kb = rr >> 6, nb = rr & 63;
        d.src = wdn + (size_t)e * EFF * D + (size_t)(64 * kb) * D + 32 * nb; d.ldsrc = D; d.dst = (bf16*)((unsigned char*)WD + (size_t)e * D * EFF + (size_t)(32 * nb) * EFF + 64 * kb); d.lddst = EFF; d.f8scale = 64.f; return d; }
}

constexpr int MOD_KS = 16;
__device__ __forceinline__ void p0_mod_item(const float* cvec, const float* wada, float* modp, int item, int lane) {
    const int cchunk = item % 192, ks = item / 192, c0 = 64 * cchunk, cg = lane & 15, rg = lane >> 4;
    f32x4 acc[4];
#pragma unroll
    for (int b = 0; b < 4; ++b) acc[b] = (f32x4){0.f, 0.f, 0.f, 0.f};
    const float* wp = wada + (size_t)(128 * ks + rg) * (6 * D) + c0 + 4 * cg;
    const float* cp = cvec + 128 * ks + rg;
#pragma unroll 8
    for (int i = 0; i < 32; ++i) {
        const f32x4 w = __builtin_nontemporal_load((const f32x4*)(wp + (size_t)(4 * i) * (6 * D)));
#pragma unroll
        for (int b = 0; b < 4; ++b) { const float sv = siluf_(cp[b * D + 4 * i]); acc[b] = acc[b] + w * sv; }
    }
#pragma unroll
    for (int b = 0; b < 4; ++b)
#pragma unroll
        for (int j = 0; j < 4; ++j) { float v = acc[b][j]; v += shx(v, 16, lane); v += shx(v, 32, lane); acc[b][j] = v; }
    if (rg == 0) {
#pragma unroll
        for (int b = 0; b < 4; ++b) *(f32x4*)(modp + ((size_t)ks * 4 + b) * (6 * D) + c0 + 4 * cg) = acc[b];
    }
}
__device__ __forceinline__ float mod_sum(const float* modp, size_t o) { float v = 0.f;
#pragma unroll
    for (int ks = 0; ks < MOD_KS; ++ks) v += modp[o + (size_t)ks * 4 * 6 * D];
    return v; }

__device__ __forceinline__ f32x16 zero16() { f32x16 z;
#pragma unroll
    for (int i = 0; i < 16; ++i) z[i] = 0.f;
    return z; }

constexpr int ATT_KS_STRIDE = 144;
constexpr int ATT_VT_STRIDE = 196;
constexpr int ATT_VT_OFF = 192 * ATT_KS_STRIDE;
__device__ __forceinline__ void swa_unit(LAS unsigned char* lds, const bf16* HC, bf16* OAOB, const float* sinks, int unit, int tid, int lane, int wave) {
    const int kvh = unit & 3, n = (unit >> 2) & 63, b = unit >> 8;
    const int nkc = n < 2 ? n + 1 : 3;
    const int key0 = (n + 1 - nkc) * 64;
    const size_t tokb = (size_t)b * SEQ;
    LAS unsigned char* Ks = lds;
    LAS unsigned short* Vt = (LAS unsigned short*)(lds + ATT_VT_OFF);
    __syncthreads();
    const int nkeys = nkc * 64;
    for (int p = tid; p < nkeys * 8; p += NTHREADS) {
        const int key = p >> 3, dc = p & 7;
        const bf16* src = HC + (tokb + key0 + key) * HC_W;
        const u32x4 kv = *(const u32x4*)(src + 1024 + kvh * 64 + dc * 8);
        const u32x4 vv = *(const u32x4*)(src + 1280 + kvh * 64 + dc * 8);
        *(LAS u32x4*)(Ks + key * ATT_KS_STRIDE + dc * 16) = kv;
        LAS unsigned short* vt = Vt + (dc * 8) * ATT_VT_STRIDE + key;
        vt[0 * ATT_VT_STRIDE] = (unsigned short)(vv.x & 0xffffu); vt[1 * ATT_VT_STRIDE] = (unsigned short)(vv.x >> 16);
        vt[2 * ATT_VT_STRIDE] = (unsigned short)(vv.y & 0xffffu); vt[3 * ATT_VT_STRIDE] = (unsigned short)(vv.y >> 16);
        vt[4 * ATT_VT_STRIDE] = (unsigned short)(vv.z & 0xffffu); vt[5 * ATT_VT_STRIDE] = (unsigned short)(vv.z >> 16);
        vt[6 * ATT_VT_STRIDE] = (unsigned short)(vv.w & 0xffffu); vt[7 * ATT_VT_STRIDE] = (unsigned short)(vv.w >> 16);
    }
    __syncthreads();
    const int g = wave >> 1, th = wave & 1, r31 = lane & 31, h = lane >> 5;
    const int head = kvh * 4 + g;
    const size_t qtok = tokb + (size_t)n * 64 + th * 32 + r31;
    bf16x8 qf[4];
#pragma unroll
    for (int ks = 0; ks < 4; ++ks) qf[ks] = *(const bf16x8*)(HC + qtok * HC_W + head * 64 + ks * 16 + 8 * h);
    const int nkt = 2 * nkc;
    f32x16 s[6];
#pragma unroll
    for (int kt = 0; kt < 6; ++kt) {
        s[kt] = zero16();
        if (kt < nkt) {
#pragma unroll
            for (int ks = 0; ks < 4; ++ks) {
                const bf16x8 A = *(const LAS bf16x8*)(Ks + (kt * 32 + r31) * ATT_KS_STRIDE + (ks * 16 + 8 * h) * 2);
                s[kt] = __builtin_amdgcn_mfma_f32_32x32x16_bf16(A, qf[ks], s[kt], 0, 0, 0);
            }
        }
    }
    const float sink = sinks[head];
    float mx = sink;
#pragma unroll
    for (int kt = 0; kt < 6; ++kt) if (kt < nkt) {
#pragma unroll
        for (int i = 0; i < 16; ++i) mx = fmaxf(mx, s[kt][i]); }
    mx = fmaxf(mx, shx(mx, 32, lane));
    float sum = 0.f;
#pragma unroll
    for (int kt = 0; kt < 6; ++kt) if (kt < nkt) {
#pragma unroll
        for (int i = 0; i < 16; ++i) { const float pv = __expf(s[kt][i] - mx); s[kt][i] = pv; sum += pv; } }
    sum += shx(sum, 32, lane);
    sum += __expf(sink - mx);
    const float inv = 1.f / sum;
    f32x16 o[2]; o[0] = zero16(); o[1] = zero16();
#pragma unroll
    for (int kt = 0; kt < 6; ++kt) if (kt < nkt) {
#pragma unroll
        for (int st = 0; st < 2; ++st) {
            u32x4 pb; pb.x = pk2(s[kt][8 * st + 0], s[kt][8 * st + 1]); pb.y = pk2(s[kt][8 * st + 2], s[kt][8 * st + 3]); pb.z = pk2(s[kt][8 * st + 4], s[kt][8 * st + 5]); pb.w = pk2(s[kt][8 * st + 6], s[kt][8 * st + 7]);
            const bf16x8 B = __builtin_bit_cast(bf16x8, pb);
#pragma unroll
            for (int mt = 0; mt < 2; ++mt) {
                const LAS unsigned short* vp = Vt + (32 * mt + r31) * ATT_VT_STRIDE + kt * 32 + 16 * st + 4 * h;
                const u32x2 a0 = *(const LAS u32x2*)vp, a1 = *(const LAS u32x2*)(vp + 8);
                u32x4 av; av.x = a0.x; av.y = a0.y; av.z = a1.x; av.w = a1.y;
                o[mt] = __builtin_amdgcn_mfma_f32_32x32x16_bf16(__builtin_bit_cast(bf16x8, av), B, o[mt], 0, 0, 0);
            }
        }
    }
    unsigned char* orow = (unsigned char*)OAOB + qtok * D + head * 64;
    const float inv4 = 4.f * inv;
#pragma unroll
    for (int mt = 0; mt < 2; ++mt)
#pragma unroll
        for (int rg = 0; rg < 4; ++rg)
            *(unsigned*)(orow + 32 * mt + 8 * rg + 4 * h) = pk_fp8x4(o[mt][4 * rg + 0] * inv4, o[mt][4 * rg + 1] * inv4, o[mt][4 * rg + 2] * inv4, o[mt][4 * rg + 3] * inv4);
}

constexpr int GU_NW = 0, GU_UT = 16384, GU_QD = 32768, GU_KDT = 49152, GU_QK = 65536, GU_BYTES = 73728;
constexpr int GP_Y = 67584, GP_SM = 67584 + 73728;
#define GP_ROW(t) ((t) * 272 + 16 * ((t) >> 3))
constexpr int GP_QN = 17520, GP_KE = 35040, GP_VB = 52560;
__host__ __device__ __forceinline__ constexpr int tri_off(int i) { const int a = i >> 2, r = i & 3; return 8 * a * a + 4 * a + (r >= 1 ? 4 * a : 0) + (r >= 2 ? 4 * a + 4 : 0) + (r == 3 ? 4 * a + 4 : 0); }

__host__ __device__ __forceinline__ constexpr int kperm4(int k) { return (k & ~31) + 8 * ((k >> 2) & 3) + 4 * ((k >> 4) & 1) + (k & 3); }
__device__ __forceinline__ void conv8(const u32x4 (&rows)[5], const LAS float* cw, float (&y)[2][8]) {
    float xr[5][8];
#pragma unroll
    for (int r = 0; r < 5; ++r) { const u32x4 w = rows[r];
        xr[r][0] = bflo(w.x); xr[r][1] = bfhi(w.x); xr[r][2] = bflo(w.y); xr[r][3] = bfhi(w.y); xr[r][4] = bflo(w.z); xr[r][5] = bfhi(w.z); xr[r][6] = bflo(w.w); xr[r][7] = bfhi(w.w); }
    float wv[4][8];
#pragma unroll
    for (int i = 0; i < 4; ++i) { const f32x4 a = *(const LAS f32x4*)(cw + i * 128), b = *(const LAS f32x4*)(cw + i * 128 + 4);
        wv[i][0] = a[0]; wv[i][1] = a[1]; wv[i][2] = a[2]; wv[i][3] = a[3]; wv[i][4] = b[0]; wv[i][5] = b[1]; wv[i][6] = b[2]; wv[i][7] = b[3]; }
#pragma unroll
    for (int d = 0; d < 8; ++d) {
        const float y0 = ((xr[0][d] * wv[0][d] + xr[1][d] * wv[1][d]) + xr[2][d] * wv[2][d]) + xr[3][d] * wv[3][d];
        const float y1 = ((xr[1][d] * wv[0][d] + xr[2][d] * wv[1][d]) + xr[3][d] * wv[2][d]) + xr[4][d] * wv[3][d];
        y[0][d] = siluf_(y0); y[1][d] = siluf_(y1);
    }
}
__device__ __forceinline__ float red16(float v, int lane) { v += shx(v, 1, lane); v += shx(v, 2, lane); v += shx(v, 4, lane); v += shx(v, 8, lane); return v; }
__device__ __forceinline__ u32x4 pack8(const float (&v)[8]) { u32x4 w; w.x = pk2(v[0], v[1]); w.y = pk2(v[2], v[3]); w.z = pk2(v[4], v[5]); w.w = pk2(v[6], v[7]); return w; }
__device__ __forceinline__ u32x2 pack4(const f32x4 v) { u32x2 w; w.x = pk2(v[0], v[1]); w.y = pk2(v[2], v[3]); return w; }

__device__ __forceinline__ void gdn_pre(LAS unsigned char* lds, const bf16* HC, const float* convw, const float* BETA, const float* GG, unsigned char* GDN, unsigned char* SCR, float* DECS, int ug, int tid, int lane, int wave) {
    asm volatile("" : "+v"(tid), "+v"(lane));
    LAS float* AM = (LAS float*)lds;
    LAS unsigned char* YR = lds + GP_Y;
    LAS float* SM = (LAS float*)(lds + GP_SM);
    const int fr = lane & 15, fq = lane >> 4;
    LAS float* CW = (LAS float*)(lds + GP_SM + 1024);
    {
        const int h0 = ((ug * 8) >> 6) & 7;
        for (int i = tid; i < 1536; i += NTHREADS) { const int ts = i >> 9, tap = (i >> 7) & 3, d = i & 127; CW[i] = convw[(size_t)tap * 3072 + ts * 1024 + h0 * 128 + d]; }
    }
    u32x4 nr[3][5]; float nbt = 0.f, ngv = 0.f;
#define GP_LOADROWS(u_) do { const int _c = (u_) & 63, _h = ((u_) >> 6) & 7, _b = (u_) >> 9; int _dg = tid & 15, _tq = tid >> 4; asm volatile("" : "+v"(_dg), "+v"(_tq));     \
        const int _t0 = 2 * _tq; const bf16* _base = HC + ((size_t)_b * SEQ + (size_t)_c * 64) * HC_W + _h * 128 + 1536 + 8 * _dg; const bool _z = (_c == 0); \
        _Pragma("unroll") for (int ts = 0; ts < 3; ++ts) _Pragma("unroll") for (int r = 0; r < 5; ++r) { const bool _zz = _z && (_t0 - 3 + r < 0); \
            const u32x4 _w = *(const u32x4*)(_base + (ptrdiff_t)(_zz ? 0 : (_t0 - 3 + r)) * HC_W + ts * 1024); \
            nr[ts][r] = _zz ? (u32x4){0u, 0u, 0u, 0u} : _w; } \
        if (wave == 0) { const size_t _tk = (size_t)_b * SEQ + (size_t)_c * 64 + lane; ngv = GG[_tk * 8 + _h]; nbt = BETA[_tk * 8 + _h]; } } while (0)
    GP_LOADROWS(ug * 8);
    const int lane_outer = lane;
#pragma unroll 1
    for (int uu = 0; uu < 8; ++uu) {
        int lane_it = lane_outer; asm volatile("" : "+v"(lane_it));
        const int lane = lane_it, tid = wave * 64 + lane_it;
        const int u = ug * 8 + uu;
        unsigned char* gb = GDN + (size_t)u * GU_BYTES;
        unsigned char* sb = SCR + (size_t)u * 32768;
        const float gv = ngv, btw = nbt;
        __syncthreads();
        if (wave == 0) {
            float xs = gv;
#pragma unroll
            for (int off = 1; off < 64; off <<= 1) { const float yv = shl_(xs, lane >= off ? lane - off : lane); if (lane >= off) xs += yv; }
            const float last = shl_(xs, 63);
            SM[lane] = xs; SM[64 + lane] = btw; SM[128 + lane] = __expf(xs); SM[192 + lane] = __expf(last - xs);
            if (lane == 0) DECS[u] = __expf(last);
        }
        __syncthreads();
        {
            int dg = tid & 15, tq = tid >> 4; asm volatile("" : "+v"(dg), "+v"(tq));
            const int t0 = 2 * tq;
            float qv[2][8], kv[2][8], vv[2][8];
            conv8(nr[0], CW + 8 * dg, qv);
            conv8(nr[1], CW + 512 + 8 * dg, kv);
            conv8(nr[2], CW + 1024 + 8 * dg, vv);
            asm volatile("" ::: "memory");
            { const int un = uu + 1 < 8 ? u + 1 : u; GP_LOADROWS(un); }
            float bt[2], ec[2], ek[2];
#pragma unroll
            for (int r = 0; r < 2; ++r) { bt[r] = SM[64 + t0 + r]; ec[r] = SM[128 + t0 + r]; ek[r] = SM[192 + t0 + r]; }
#pragma unroll
            for (int r = 0; r < 2; ++r) {
                float sq = 0.f, sk = 0.f;
#pragma unroll
                for (int d = 0; d < 8; ++d) { sq += qv[r][d] * qv[r][d]; sk += kv[r][d] * kv[r][d]; }
                sq = red16(sq, lane); sk = red16(sk, lane);
                const float rq = rsqrtf(sq + 1e-6f) * 0.08838834764831845f, rk = rsqrtf(sk + 1e-6f);
                float qd[8];
#pragma unroll
                for (int d = 0; d < 8; ++d) { qv[r][d] *= rq; kv[r][d] *= rk; qd[d] = qv[r][d] * ec[r]; }
                const int ro = GP_ROW(t0 + r) + 16 * dg;
                *(LAS u32x4*)(YR + ro) = pack8(kv[r]);
                *(LAS u32x4*)(YR + GP_QN + ro) = pack8(qv[r]);
                { float ke[8], vb[8];
#pragma unroll
                  for (int d = 0; d < 8; ++d) { ke[d] = kv[r][d] * ek[r]; vb[d] = vv[r][d] * bt[r]; }
                  *(LAS u32x4*)(YR + GP_KE + ro) = pack8(ke); *(LAS u32x4*)(YR + GP_VB + ro) = pack8(vb); }
                { const u32x4 w8 = pack8(qd); *(u32x2*)(gb + GU_QD + ((t0 + r) * 128 + kperm4(8 * dg)) * 2) = (u32x2){w8.x, w8.y}; *(u32x2*)(gb + GU_QD + ((t0 + r) * 128 + kperm4(8 * dg + 4)) * 2) = (u32x2){w8.z, w8.w}; }
            }
        }
        __syncthreads();
        {
#pragma unroll
            for (int q = 0; q < 2; ++q) {
                int pp = tid + q * NTHREADS; asm volatile("" : "+v"(pp));
                const int d = pp >> 3, j = pp & 7;
                const LAS unsigned char* colp = YR + 2 * d;
                unsigned hv[8];
#pragma unroll
                for (int k = 0; k < 8; ++k) hv[k] = *(const LAS unsigned short*)(colp + GP_VB + GP_ROW(8 * j + k));
                { u32x4 w; w.x = hv[0] | (hv[1] << 16); w.y = hv[2] | (hv[3] << 16); w.z = hv[4] | (hv[5] << 16); w.w = hv[6] | (hv[7] << 16); *(u32x4*)(sb + (d * 64 + 8 * j) * 2) = w; }
                { float kb[8];
#pragma unroll
                  for (int k = 0; k < 8; ++k) { const int t = 8 * j + k; kb[k] = __uint_as_float((unsigned)(*(const LAS unsigned short*)(colp + GP_ROW(t))) << 16) * (SM[64 + t] * SM[128 + t]); }
                  *(u32x4*)(sb + 16384 + (d * 64 + 8 * j) * 2) = pack8(kb); }
                { const int tb = 32 * (j >> 2) + 4 * (j & 3);
#pragma unroll
                  for (int k = 0; k < 8; ++k) hv[k] = *(const LAS unsigned short*)(colp + GP_KE + GP_ROW(tb + (k & 3) + 16 * (k >> 2)));
                  u32x4 w; w.x = hv[0] | (hv[1] << 16); w.y = hv[2] | (hv[3] << 16); w.z = hv[4] | (hv[5] << 16); w.w = hv[6] | (hv[7] << 16); *(u32x4*)(gb + GU_KDT + (d * 64 + 8 * j) * 2) = w; }
            }
        }
        {
            const int mt = wave & 3;
            int fr = lane & 15, fq = lane >> 4; asm volatile("" : "+v"(fr), "+v"(fq));
            if (wave < 4) {
#pragma unroll
                for (int nt = 0; nt < 4; ++nt) if (nt <= mt) {
                    f32x4 cacc = (f32x4){0.f, 0.f, 0.f, 0.f};
#pragma unroll
                    for (int sx = 0; sx < 4; ++sx) {
                        const bf16x8 A = *(const LAS bf16x8*)(YR + GP_ROW(16 * mt + fr) + (32 * sx + 8 * fq) * 2), B = *(const LAS bf16x8*)(YR + GP_ROW(16 * nt + fr) + (32 * sx + 8 * fq) * 2);
                        cacc = __builtin_amdgcn_mfma_f32_16x16x32_bf16(A, B, cacc, 0, 0, 0);
                    }
                    const int jj = 16 * nt + fr; const float cj = SM[jj];
#pragma unroll
                    for (int r = 0; r < 4; ++r) { const int i = 16 * mt + 4 * fq + r;
                        const float val = (i > jj) ? SM[64 + i] * cacc[r] * __expf(SM[i] - cj) : 0.f;
                        if (jj < ((i + 3) & ~3)) AM[uu * 2112 + tri_off(i) + jj] = val; }
                }
            } else {
#pragma unroll
                for (int jp = 0; jp < 2; ++jp) {
                    u32x2 half[2];
#pragma unroll
                    for (int jh = 0; jh < 2; ++jh) { const int jt = 2 * jp + jh;
                        f32x4 cacc = (f32x4){0.f, 0.f, 0.f, 0.f};
                        if (jt <= mt) {
#pragma unroll
                            for (int sx = 0; sx < 4; ++sx) {
                                const bf16x8 A = *(const LAS bf16x8*)(YR + GP_ROW(16 * jt + fr) + (32 * sx + 8 * fq) * 2), B = *(const LAS bf16x8*)(YR + GP_QN + GP_ROW(16 * mt + fr) + (32 * sx + 8 * fq) * 2);
                                cacc = __builtin_amdgcn_mfma_f32_16x16x32_bf16(A, B, cacc, 0, 0, 0);
                            }
                        }
                        const int i = 16 * mt + fr; const float ci = SM[i];
                        f32x4 o;
#pragma unroll
                        for (int r = 0; r < 4; ++r) { const int jj = 16 * jt + 4 * fq + r; o[r] = (i >= jj) ? cacc[r] * __expf(ci - SM[jj]) : 0.f; }
                        half[jh] = pack4(o); }
                    *(u32x4*)(gb + GU_QK + ((16 * mt + fr) * 64 + 32 * jp + 8 * fq) * 2) = (u32x4){half[0].x, half[0].y, half[1].x, half[1].y};
                }
            }
        }
    }
#undef GP_LOADROWS
    __syncthreads();
    {
        const LAS float* A = AM + wave * 2112;
        int lo = lane; asm volatile("" : "+v"(lo));
        float T[64];
#pragma unroll
        for (int i = 0; i < 64; ++i) {
            float acc = (lo == i) ? 1.f : 0.f;
#pragma unroll
            for (int j4 = 0; j4 < i; j4 += 4) {
                const f32x4 av = *(const LAS f32x4*)(A + tri_off(i) + j4);
                acc -= av[0] * T[j4];
                if (j4 + 1 < i) acc -= av[1] * T[j4 + 1];
                if (j4 + 2 < i) acc -= av[2] * T[j4 + 2];
                if (j4 + 3 < i) acc -= av[3] * T[j4 + 3];
            }
            T[i] = acc;
        }
        LAS unsigned short* Tb = (LAS unsigned short*)YR + wave * (64 * 72);
#pragma unroll
        for (int i = 0; i < 64; ++i) { const __bf16 hb = (__bf16)T[i]; Tb[i * 72 + lo] = __builtin_bit_cast(unsigned short, hb); }
    }
    asm volatile("" : "+v"(tid), "+v"(lane));
    const int frc = lane & 15, fqc = lane >> 4;
    u32x4 pv[4];
#define GP_LOADVK(u_) do { const unsigned char* _sb = SCR + (size_t)(u_) * 32768; int _t = tid; asm volatile("" : "+v"(_t)); \
        _Pragma("unroll") for (int q = 0; q < 4; ++q) { const int p = _t + q * NTHREADS, ts = p >> 10, pp = p & 1023, d = pp >> 3, ch = pp & 7; pv[q] = *(const u32x4*)(_sb + ts * 16384 + (d * 64 + ch * 8) * 2); } } while (0)
    GP_LOADVK(ug * 8);
#pragma unroll 1
    for (int uu = 0; uu < 8; ++uu) {
        const int u = ug * 8 + uu;
        unsigned char* gb = GDN + (size_t)u * GU_BYTES;
        __syncthreads();
#pragma unroll
        for (int q = 0; q < 4; ++q) { const int p = tid + q * NTHREADS, ts = p >> 10, pp = p & 1023, d = pp >> 3, ch = pp & 7; *(LAS u32x4*)(lds + ts * 18432 + d * 144 + ch * 16) = pv[q]; }
        { const int un = uu + 1 < 8 ? u + 1 : u; GP_LOADVK(un); }
        __syncthreads();
        const LAS unsigned char* Tu = YR + uu * 9216;
#pragma unroll
        for (int mt = 0; mt < 4; ++mt) {
            f32x4 cu = (f32x4){0.f, 0.f, 0.f, 0.f}, cw = (f32x4){0.f, 0.f, 0.f, 0.f};
#pragma unroll
            for (int sx = 0; sx < 2; ++sx) {
                const bf16x8 Tf = *(const LAS bf16x8*)(Tu + ((16 * mt + frc) * 72 + 32 * sx + 8 * fqc) * 2);
                const bf16x8 Vf = *(const LAS bf16x8*)(lds + ((16 * wave + frc) * 72 + 32 * sx + 8 * fqc) * 2);
                const bf16x8 Kf = *(const LAS bf16x8*)(lds + 18432 + ((16 * wave + frc) * 72 + 32 * sx + 8 * fqc) * 2);
                cu = __builtin_amdgcn_mfma_f32_16x16x32_bf16(Tf, Vf, cu, 0, 0, 0);
                cw = __builtin_amdgcn_mfma_f32_16x16x32_bf16(Kf, Tf, cw, 0, 0, 0);
            }
            *(u32x2*)(gb + GU_UT + ((16 * wave + frc) * 64 + 16 * mt + 4 * fqc) * 2) = pack4(cu);
            *(u32x2*)(gb + GU_NW + ((16 * mt + frc) * 128 + kperm4(16 * wave + 4 * fqc)) * 2) = pack4(-cw);
        }
    }
#undef GP_LOADVK
}

__device__ __forceinline__ bf16x8 lda2(const LAS unsigned char* p) { const u32x2 a0 = *(const LAS u32x2*)p, a1 = *(const LAS u32x2*)(p + 32); u32x4 av; av.x = a0.x; av.y = a0.y; av.z = a1.x; av.w = a1.y; return __builtin_bit_cast(bf16x8, av); }
__device__ __forceinline__ bf16x8 packB(const f32x4 t0, const f32x4 t1) { u32x4 w; w.x = pk2(t0[0], t0[1]); w.y = pk2(t0[2], t0[3]); w.z = pk2(t1[0], t1[1]); w.w = pk2(t1[2], t1[3]); return __builtin_bit_cast(bf16x8, w); }

constexpr int SB_NW = 0, SB_QD = 17408, SB_KDT = 34816, SB_QK = 53248, SB_BYTES = 62464;
__device__ __forceinline__ float dpp_xor1(float v) { return __int_as_float(__builtin_amdgcn_update_dpp(0, __float_as_int(v), 0xB1, 0xF, 0xF, false)); }
__device__ __forceinline__ float dpp_xor2(float v) { return __int_as_float(__builtin_amdgcn_update_dpp(0, __float_as_int(v), 0x4E, 0xF, 0xF, false)); }
__device__ __forceinline__ float dpp_xor4(float v) { int t = __builtin_amdgcn_update_dpp(0, __float_as_int(v), 0x104, 0xF, 0x5, false);
    t = __builtin_amdgcn_update_dpp(t, __float_as_int(v), 0x114, 0xF, 0xA, false); return __int_as_float(t); }
__device__ __forceinline__ float dpp_xor8(float v) { return __int_as_float(__builtin_amdgcn_update_dpp(0, __float_as_int(v), 0x128, 0xF, 0xF, false)); }
__device__ __forceinline__ float tred16(const float (&v)[16], int fr) {
    float a[8], b[4], c[2];
#pragma unroll
    for (int i = 0; i < 8; ++i) { const bool up = (fr & 8) != 0; const float keep = up ? v[i + 8] : v[i], send = up ? v[i] : v[i + 8]; a[i] = keep + dpp_xor8(send); }
#pragma unroll
    for (int i = 0; i < 4; ++i) { const bool up = (fr & 4) != 0; const float keep = up ? a[i + 4] : a[i], send = up ? a[i] : a[i + 4]; b[i] = keep + dpp_xor4(send); }
#pragma unroll
    for (int i = 0; i < 2; ++i) { const bool up = (fr & 2) != 0; const float keep = up ? b[i + 2] : b[i], send = up ? b[i] : b[i + 2]; c[i] = keep + dpp_xor2(send); }
    const bool up = (fr & 1) != 0; const float keep = up ? c[1] : c[0], send = up ? c[0] : c[1];
    return keep + dpp_xor1(send);
}
__device__ __forceinline__ void gdn_scan(LAS unsigned char* lds, const unsigned char* GDN, const float* DECS, const bf16* HC, const float* normw, bf16* OAOB, float* SSQ, int bh, int half, int tid, int lane, int wave) {
    constexpr int SQ_OFF = 2 * SB_BYTES, OT_OFF = SQ_OFF + 2048, OT_STRIDE = 144, OT_BYTES = 64 * OT_STRIDE;
    LAS float* SQ = (LAS float*)(lds + SQ_OFF);
    LAS unsigned char* OT = lds + OT_OFF;
    LAS float* NWL = (LAS float*)(lds + OT_OFF + 2 * OT_BYTES);
    LAS float* DL = NWL + 64;
    const int fr = lane & 15, fq = lane >> 4, b = bh >> 3, h = bh & 7;
    if (tid < 64) { NWL[tid] = normw[64 * half + tid]; DL[tid] = DECS[bh * 64 + tid]; }
    const unsigned char* gbase = GDN + (size_t)bh * 64 * GU_BYTES;
    if (wave < 4) {
        const int cw = wave, dvl = 16 * cw + fr, dv = 64 * half + dvl;
        const int myrow = 16 * (fr >> 2) + 4 * fq + (fr & 3);
        const int uo = GU_UT + (dv * 64 + 4 * fq) * 2;
        u32x2 UA[4], UB[4];
#define SC_LOADU(cc, U) do { const unsigned char* _g = gbase + (size_t)(cc) * GU_BYTES + uo; _Pragma("unroll") for (int mt = 0; mt < 4; ++mt) U[mt] = *(const u32x2*)(_g + 32 * mt); } while (0)
        SC_LOADU(0, UA); SC_LOADU(1, UB);
        f32x4 S[8];
#pragma unroll
        for (int kt = 0; kt < 8; ++kt) S[kt] = (f32x4){0.f, 0.f, 0.f, 0.f};
        __syncthreads();
        auto cstep = [&](const int c, u32x2 (&U)[4]) __attribute__((always_inline)) {
            const int cur = c & 1;
            const LAS unsigned char* L = lds + cur * SB_BYTES;
            f32x4 vn[4], o[4];
#pragma unroll
            for (int mt = 0; mt < 4; ++mt) vn[mt] = (f32x4){bflo(U[mt].x), bfhi(U[mt].x), bflo(U[mt].y), bfhi(U[mt].y)};
            { const int c2 = c + 2 < 64 ? c + 2 : 63; SC_LOADU(c2, U); }
            const float cdec = DL[c];
            bf16x8 bS[4];
#pragma unroll
            for (int sx = 0; sx < 4; ++sx) bS[sx] = packB(S[2 * sx], S[2 * sx + 1]);
#define SC_FRAG(base, row, stride, sx) (*(const LAS bf16x8*)(L + (base) + (row) * (stride) + (32 * (sx) + 8 * fq) * 2))
#define SC_SB __builtin_amdgcn_sched_barrier(0)
            bf16x8 f0[8], f1[8];
            SC_SB;
#pragma unroll
            for (int q = 0; q < 8; ++q) f0[q] = SC_FRAG(SB_NW, 16 * (q >> 2) + fr, 272, q & 3);
            SC_SB;
#pragma unroll
            for (int q = 0; q < 8; ++q) f1[q] = SC_FRAG(SB_NW, 16 * (2 + (q >> 2)) + fr, 272, q & 3);
#pragma unroll
            for (int q = 0; q < 8; ++q) vn[q >> 2] = __builtin_amdgcn_mfma_f32_16x16x32_bf16(f0[q], bS[q & 3], vn[q >> 2], 0, 0, 0);
            SC_SB;
#pragma unroll
            for (int q = 0; q < 8; ++q) f0[q] = SC_FRAG(SB_QD, 16 * (q >> 2) + fr, 272, q & 3);
#pragma unroll
            for (int q = 0; q < 8; ++q) vn[2 + (q >> 2)] = __builtin_amdgcn_mfma_f32_16x16x32_bf16(f1[q], bS[q & 3], vn[2 + (q >> 2)], 0, 0, 0);
            SC_SB;
#pragma unroll
            for (int mt = 0; mt < 4; ++mt) o[mt] = (f32x4){0.f, 0.f, 0.f, 0.f};
#pragma unroll
            for (int q = 0; q < 8; ++q) f1[q] = SC_FRAG(SB_QD, 16 * (2 + (q >> 2)) + fr, 272, q & 3);
#pragma unroll
            for (int q = 0; q < 8; ++q) o[q >> 2] = __builtin_amdgcn_mfma_f32_16x16x32_bf16(f0[q], bS[q & 3], o[q >> 2], 0, 0, 0);
            SC_SB;
            bf16x8 bV[2];
            bV[0] = packB(vn[0], vn[1]); bV[1] = packB(vn[2], vn[3]);
#pragma unroll
            for (int q = 0; q < 8; ++q) f0[q] = SC_FRAG(SB_QK, 16 * (q >> 1) + fr, 144, q & 1);
#pragma unroll
            for (int q = 0; q < 8; ++q) o[2 + (q >> 2)] = __builtin_amdgcn_mfma_f32_16x16x32_bf16(f1[q], bS[q & 3], o[2 + (q >> 2)], 0, 0, 0);
            SC_SB;
#pragma unroll
            for (int q = 0; q < 8; ++q) f1[q] = SC_FRAG(SB_KDT, 16 * (q >> 1) + fr, 144, q & 1);
#pragma unroll
            for (int q = 0; q < 8; ++q) o[q >> 1] = __builtin_amdgcn_mfma_f32_16x16x32_bf16(f0[q], bV[q & 1], o[q >> 1], 0, 0, 0);
            SC_SB;
#pragma unroll
            for (int kt = 0; kt < 8; ++kt) S[kt] = S[kt] * cdec;
#pragma unroll
            for (int q = 0; q < 8; ++q) f0[q] = SC_FRAG(SB_KDT, 16 * (4 + (q >> 1)) + fr, 144, q & 1);
#pragma unroll
            for (int q = 0; q < 8; ++q) S[q >> 1] = __builtin_amdgcn_mfma_f32_16x16x32_bf16(f1[q], bV[q & 1], S[q >> 1], 0, 0, 0);
            SC_SB;
#pragma unroll
            for (int q = 0; q < 8; ++q) S[4 + (q >> 1)] = __builtin_amdgcn_mfma_f32_16x16x32_bf16(f0[q], bV[q & 1], S[4 + (q >> 1)], 0, 0, 0);
            SC_SB;
#undef SC_FRAG
#undef SC_SB
            float ssv[16];
            LAS unsigned short* ot = (LAS unsigned short*)(OT + cur * OT_BYTES + (4 * fq) * OT_STRIDE + dvl * 2);
#pragma unroll
            for (int mt = 0; mt < 4; ++mt)
#pragma unroll
                for (int r = 0; r < 4; ++r) { ssv[mt * 4 + r] = o[mt][r] * o[mt][r]; const __bf16 hb = (__bf16)o[mt][r]; ot[((16 * mt + r) * OT_STRIDE) / 2] = __builtin_bit_cast(unsigned short, hb); }
            SQ[cur * 256 + myrow * 4 + cw] = tred16(ssv, fr);
            asm volatile("s_waitcnt lgkmcnt(0)" ::: "memory"); __builtin_amdgcn_s_barrier(); asm volatile("" ::: "memory");
        };
#pragma unroll 1
        for (int c = 0; c < 64; c += 2) { cstep(c, UA); cstep(c + 1, UB); }
#undef SC_LOADU
    } else {
        const int t = tid - 256;
        const int r16 = t >> 4, c16 = t & 15, r8 = t >> 3, c8 = t & 7;
        const int go = t * 16;
        const int dA = r16 * 272 + c16 * 16, dB = r8 * 144 + c8 * 16;
        u32x4 X[14], Y[14], ZA[2], ZB[2];
#define SC_LOADX(cc, P) do { const unsigned char* _g = gbase + (size_t)(cc) * GU_BYTES + go; \
        _Pragma("unroll") for (int j = 0; j < 4; ++j) { P[j] = *(const u32x4*)(_g + GU_NW + 4096 * j); P[4 + j] = *(const u32x4*)(_g + GU_QD + 4096 * j); P[8 + j] = *(const u32x4*)(_g + GU_KDT + 4096 * j); } \
        P[12] = *(const u32x4*)(_g + GU_QK); P[13] = *(const u32x4*)(_g + GU_QK + 4096); } while (0)
#define SC_STOREX(bufsel, P) do { LAS unsigned char* _l = lds + (bufsel) * SB_BYTES; \
        _Pragma("unroll") for (int j = 0; j < 4; ++j) { *(LAS u32x4*)(_l + SB_NW + dA + 16 * 272 * j) = P[j]; *(LAS u32x4*)(_l + SB_QD + dA + 16 * 272 * j) = P[4 + j]; *(LAS u32x4*)(_l + SB_KDT + dB + 32 * 144 * j) = P[8 + j]; } \
        *(LAS u32x4*)(_l + SB_QK + dB) = P[12]; *(LAS u32x4*)(_l + SB_QK + dB + 32 * 144) = P[13]; } while (0)
#define SC_LOADZ(cc, Z) do { const bf16* _z = HC + ((size_t)b * SEQ + (size_t)(cc) * 64 + r8) * HC_W + 4608 + h * 128 + 64 * half + 8 * c8; Z[0] = *(const u32x4*)_z; Z[1] = *(const u32x4*)(_z + (size_t)32 * HC_W); } while (0)
        auto ostage = [&](const int cc, const u32x4 (&Z)[2]) __attribute__((always_inline)) {
            const int ob = cc & 1;
            const size_t tok0 = (size_t)b * SEQ + (size_t)cc * 64;
            const f32x4 nwa = *(const LAS f32x4*)(NWL + 8 * c8), nwb = *(const LAS f32x4*)(NWL + 8 * c8 + 4);
#pragma unroll
            for (int j = 0; j < 2; ++j) {
                const int row = r8 + 32 * j;
                const u32x4 ov = *(const LAS u32x4*)(OT + ob * OT_BYTES + row * OT_STRIDE + c8 * 16);
                const u32x4 zq = Z[j];
                float w8[8];
                w8[0] = bflo(ov.x) * bflo(zq.x) * nwa[0]; w8[1] = bfhi(ov.x) * bfhi(zq.x) * nwa[1]; w8[2] = bflo(ov.y) * bflo(zq.y) * nwa[2]; w8[3] = bfhi(ov.y) * bfhi(zq.y) * nwa[3];
                w8[4] = bflo(ov.z) * bflo(zq.z) * nwb[0]; w8[5] = bfhi(ov.z) * bfhi(zq.z) * nwb[1]; w8[6] = bflo(ov.w) * bflo(zq.w) * nwb[2]; w8[7] = bfhi(ov.w) * bfhi(zq.w) * nwb[3];
                *(u32x4*)(OAOB + (tok0 + row) * D + 1024 + h * 128 + 64 * half + 8 * c8) = pack8(w8);
                if (c8 == 0) { const f32x4 p0 = *(const LAS f32x4*)(SQ + ob * 256 + row * 4); SSQ[((size_t)half * MTOK + tok0 + row) * 8 + h] = (p0[0] + p0[1]) + (p0[2] + p0[3]); }
            }
        };
        SC_LOADX(0, X); SC_STOREX(0, X);
        SC_LOADX(1, X); SC_LOADX(2, Y);
        SC_LOADZ(0, ZA); SC_LOADZ(1, ZB);
        __syncthreads();
        SC_STOREX(1, X); SC_LOADX(3, X);
        asm volatile("s_waitcnt lgkmcnt(0)" ::: "memory"); __builtin_amdgcn_s_barrier(); asm volatile("" ::: "memory");
        auto sstep = [&](const int c, u32x4 (&P)[14], u32x4 (&Z)[2]) __attribute__((always_inline)) {
            SC_STOREX((c & 1) ^ 1, P);
            { const int c3 = c + 3 < 64 ? c + 3 : 63; SC_LOADX(c3, P); }
            ostage(c - 1, Z);
            { const int c1 = c + 1 < 64 ? c + 1 : 63; SC_LOADZ(c1, Z); }
            asm volatile("s_waitcnt lgkmcnt(0)" ::: "memory"); __builtin_amdgcn_s_barrier(); asm volatile("" ::: "memory");
        };
#pragma unroll 1
        for (int c = 1; c < 63; c += 2) { sstep(c, Y, ZA); sstep(c + 1, X, ZB); }
        sstep(63, Y, ZA);
        ostage(63, ZB);
#undef SC_LOADX
#undef SC_STOREX
#undef SC_LOADZ
    }
    __syncthreads();
}

__device__ __forceinline__ void moe_weight_items(LAS unsigned char* lds, const float* wgu, const float* wdn, bf16* WGU, bf16* WD, int w0, int nw, int lane, int wave) {
    LAS float* scr = (LAS float*)(lds + wave * 16384);
    f32x4 va[8], vb[8];
    int it = w0;
    if (it < TI_MOE) { const TDesc d = moe_desc(it, wgu, wdn, WGU, WD); t_load(d, lane, va); }
    while (it < TI_MOE) {
        const int nit = it + nw;
        if (nit < TI_MOE) { const TDesc dn = moe_desc(nit, wgu, wdn, WGU, WD); t_load(dn, lane, vb); }
        { const TDesc d = moe_desc(it, wgu, wdn, WGU, WD); t_store(d, va, scr, lane); }
#pragma unroll
        for (int q = 0; q < 8; ++q) va[q] = vb[q];
        it = nit;
    }
}

__global__ void __launch_bounds__(NTHREADS, 2) fwd(Args a) {
    extern __shared__ __attribute__((aligned(16))) unsigned char lds_raw[];
    LAS unsigned char* lds = (LAS unsigned char*)lds_raw;
    const int wave = __builtin_amdgcn_readfirstlane((int)threadIdx.x >> 6);
    const int G = gridDim.x;
#define PHASE_IDS int lane = hw_lane(); asm volatile("" : "+v"(lane)); const int tid = wave * 64 + lane; const int gt = blockIdx.x * NTHREADS + tid; (void)lane; (void)gt
    volatile LAS unsigned* LCTL = (volatile LAS unsigned*)(lds + LDSCTL_OFF);
    { PHASE_IDS; for (int u = tid; u < 256; u += NTHREADS) LCTL[u] = 0u; }
    __syncthreads();
    unsigned char* ws = a.ws;
    unsigned* ctl = (unsigned*)(ws + WS_CTL);
    XcdBarrier bar = xcd_barrier_post(ctl + CW_BAR, LCTL + 8, wave == 0);

    const float* x = a.in[I_X];
#define MODP ((float*)(a.ws + WS_OAOB))
#define MOD ((float*)(a.ws + WS_MOD))
#define WRH ((bf16*)(a.ws + WS_WRH))
#define WRL ((bf16*)(a.ws + WS_WRL))
#define WGU ((bf16*)(a.ws + WS_WGU))
#define WD ((bf16*)(a.ws + WS_WD))
#define U ((bf16*)(a.ws + WS_U))
#define ULO ((bf16*)(a.ws + WS_ULO))
#define HB ((bf16*)(a.ws + WS_H))
#define YB ((bf16*)(a.ws + WS_Y))
#define TOKLIST ((int*)(a.ws + WS_TOKLIST))
#define RI ((i32x4*)(a.ws + WS_RI))
#define RW ((f32x2*)(a.ws + WS_RW))
#define CNT ((unsigned*)(a.ws + WS_CTL) + CW_CNT)
#define WIN ((bf16*)(a.ws + WS_WIN))
#define WP ((bf16*)(a.ws + WS_WP))
#define WOUT ((bf16*)(a.ws + WS_WOUT))
#define WBD ((float*)(a.ws + WS_WBD))
#define BETA ((float*)(a.ws + WS_BG))
#define GG (BETA + (size_t)MTOK * 8)
#define HC ((bf16*)(a.ws + WS_HCAT))
#define OAOB ((bf16*)(a.ws + WS_OAOB))
#define MERGED ((bf16*)(a.ws + WS_MERGED))
    const int gw = blockIdx.x * NWAVES + wave, NGW = G * NWAVES;
    const int NGT = G * NTHREADS;

    {
        PHASE_IDS;
        LAS float* scr = (LAS float*)(lds + wave * 16384);
        for (int it = gw; it < 192 * MOD_KS; it += NGW) p0_mod_item(a.in[I_C], a.in[I_WADA], MODP, it, lane);
        {
            f32x4 va[8], vb[8];
            int it = gw;
            if (it < TI_P0) { const TDesc d = p0_desc(it, a.in[I_WIN], a.in[I_WPA], a.in[I_WPB], a.in[I_WOUT], WIN, WP, WOUT); t_load(d, lane, va); }
            while (it < TI_P0) {
                const int nit = it + NGW;
                if (nit < TI_P0) { const TDesc dn = p0_desc(nit, a.in[I_WIN], a.in[I_WPA], a.in[I_WPB], a.in[I_WOUT], WIN, WP, WOUT); t_load(dn, lane, vb); }
                { const TDesc d = p0_desc(it, a.in[I_WIN], a.in[I_WPA], a.in[I_WPB], a.in[I_WOUT], WIN, WP, WOUT); t_store(d, va, scr, lane); }
#pragma unroll
                for (int q = 0; q < 8; ++q) va[q] = vb[q];
                it = nit;
            }
        }
        for (int i = gt; i < 48 * D; i += NGT) { const int n = i / D, k = i - n * D;
            const float w = n < 32 ? a.in[I_WRE][(size_t)k * 32 + n] : (n < 36 ? a.in[I_WRG][(size_t)k * 4 + (n - 32)] : 0.f);
            const __bf16 hi = (__bf16)w; const float hf = (float)hi; const __bf16 lo = (__bf16)(w - hf);
            WRH[i] = __builtin_bit_cast(unsigned short, hi); WRL[i] = __builtin_bit_cast(unsigned short, lo); }
        for (int i = gt; i < 16 * D; i += NGT) { const int c = i / D, k = i - c * D; WBD[i] = a.in[I_WIN][(size_t)k * IN_W + 5632 + c]; }
    }
    xcd_barrier(bar);
    {
    PHASE_IDS;
    for (int i = gt; i < 4 * 6 * D; i += NGT) { const int n = i % (6 * D);
        MOD[i] = mod_sum(MODP, (size_t)i) + a.in[I_BADA][n]; }
    {
        LAS float* VEC = (LAS float*)lds;
        LAS float* WL = (LAS float*)(lds + 16384);
        for (int i = tid; i < 16 * D; i += NTHREADS) WL[i] = WBD[i];
        for (int grp = blockIdx.x; grp < MTOK / 64; grp += G) {
            const int b = (grp * 64) / SEQ;
            __syncthreads();
            for (int i = tid; i < 2 * D; i += NTHREADS) { const int n = i < D ? D + i : i - D; const size_t o = (size_t)b * 6 * D + n;
                const float v = mod_sum(MODP, o) + a.in[I_BADA][n];
                VEC[i] = i < D ? 1.f + v : v; }
            __syncthreads();
            const int mb = grp * 64 + wave * 8;
            f32x4 cur[2][8], nxt[2][8];
#pragma unroll
            for (int q = 0; q < 2; ++q) { const f32x4* xr = (const f32x4*)(x + (size_t)(mb + q) * D) + lane;
#pragma unroll
                for (int j = 0; j < 8; ++j) cur[q][j] = xr[64 * j]; }
#pragma unroll 1
            for (int rr = 0; rr < 8; rr += 2) {
                const int mn = mb + (rr + 2 < 8 ? rr + 2 : rr);
#pragma unroll
                for (int q = 0; q < 2; ++q) { const f32x4* xr = (const f32x4*)(x + (size_t)(mn + q) * D) + lane;
#pragma unroll
                    for (int j = 0; j < 8; ++j) nxt[q][j] = xr[64 * j]; }
                ln_norm(cur[0], lane); ln_norm(cur[1], lane);
#pragma unroll
                for (int j = 0; j < 8; ++j) { const f32x4 sc = *(const LAS f32x4*)(VEC + 4 * lane + 256 * j), sh = *(const LAS f32x4*)(VEC + D + 4 * lane + 256 * j);
#pragma unroll
                    for (int q = 0; q < 2; ++q) { cur[q][j] = cur[q][j] * sc + sh;
                        ((unsigned*)((unsigned char*)U + (size_t)(mb + rr + q) * D) + lane)[64 * j] = pk_fp8x4(cur[q][j][0], cur[q][j][1], cur[q][j][2], cur[q][j][3]); } }
                float mine0 = 0.f, mine1 = 0.f;
#pragma unroll 1
                for (int c = 0; c < 16; ++c) { float a0 = 0.f, a1 = 0.f;
                    asm volatile("" ::: "memory");
#pragma unroll
                    for (int j = 0; j < 8; ++j) { const f32x4 w = *(const LAS f32x4*)(WL + c * D + 4 * lane + 256 * j);
                        a0 += (cur[0][j][0] * w[0] + cur[0][j][1] * w[1]) + (cur[0][j][2] * w[2] + cur[0][j][3] * w[3]);
                        a1 += (cur[1][j][0] * w[0] + cur[1][j][1] * w[1]) + (cur[1][j][2] * w[2] + cur[1][j][3] * w[3]); }
#pragma unroll
                    for (int o = 1; o < 64; o <<= 1) { a0 += shx(a0, o, lane); a1 += shx(a1, o, lane); }
                    mine0 = (lane == c) ? a0 : mine0; mine1 = (lane == c) ? a1 : mine1; }
#pragma unroll
                for (int q = 0; q < 2; ++q) { const float mine = q ? mine1 : mine0; const size_t m = (size_t)(mb + rr + q);
                    if (lane < 8) BETA[m * 8 + lane] = sigmoidf_(mine);
                    else if (lane < 16) { const int hh = lane - 8; const float z = mine + a.in[I_DTB][hh]; const float sp = z > 20.f ? z : log1pf(__expf(z)); GG[m * 8 + hh] = -__expf(a.in[I_ALOG][hh]) * sp; } }
#pragma unroll
                for (int q = 0; q < 2; ++q)
#pragma unroll
                    for (int j = 0; j < 8; ++j) cur[q][j] = nxt[q][j];
            }
        }
    }
    }
    xcd_barrier(bar);
    {
        pg8::StaticOrder S; S.init(U, WIN, MTOK, HC_W, D / 2, G, blockIdx.x);
        pg8::EpiHcat E{HC, 1.f / 64.f};
        { const int nwg = (MTOK / 256) * (HC_W / 256), first = nwg % G;
          if (first != 0 && (int)blockIdx.x >= first) { const int pop = ((int)blockIdx.x - first) * 3 / (G - first);
              for (int i = 0; i < 2 * (pop + 1); ++i) __builtin_amdgcn_s_sleep(127); } }
        pg8::gemm_phase<pg8::EpiHcat, pg8::StaticOrder, false, false, true>(lds, S, E, wave);
    }
    xcd_barrier(bar);
    {
        PHASE_IDS;
        float* DECS = BETA + (size_t)MTOK * 16;
        for (int ug = blockIdx.x; ug < 256; ug += G) gdn_pre(lds, HC, a.in[I_CONVW], BETA, GG, ws + WS_GDN, ws + WS_MERGED, DECS, ug, tid, lane, wave);
    }
    xcd_barrier(bar);
    {
        PHASE_IDS;
        const float* DECS = BETA + (size_t)MTOK * 16;
        float* SSQ = (float*)(ws + WS_MODP);
        const int nsc = G > 128 ? 64 : 0;
        if (nsc) {
            if ((int)blockIdx.x < nsc) gdn_scan(lds, ws + WS_GDN, DECS, HC, a.in[I_NORMW], OAOB, SSQ, blockIdx.x >> 1, blockIdx.x & 1, tid, lane, wave);
            else {
                for (int unit = blockIdx.x - nsc; unit < BATCH * 64 * 4; unit += G - nsc) swa_unit(lds, HC, (bf16*)(ws + WS_U + 32 * MiB), a.in[I_SINKS], unit, tid, lane, wave);
                __syncthreads();
                moe_weight_items(lds, a.in[I_WGU], a.in[I_WDN], WGU, WD, (blockIdx.x - nsc) * NWAVES + wave, (G - nsc) * NWAVES, lane, wave);
            }
        } else {
            for (int w = blockIdx.x; w < 64; w += G) gdn_scan(lds, ws + WS_GDN, DECS, HC, a.in[I_NORMW], OAOB, SSQ, w >> 1, w & 1, tid, lane, wave);
            for (int unit = blockIdx.x; unit < BATCH * 64 * 4; unit += G) swa_unit(lds, HC, (bf16*)(ws + WS_U + 32 * MiB), a.in[I_SINKS], unit, tid, lane, wave);
            __syncthreads();
            moe_weight_items(lds, a.in[I_WGU], a.in[I_WDN], WGU, WD, blockIdx.x * NWAVES + wave, G * NWAVES, lane, wave);
        }
    }
    xcd_barrier(bar);
    {
        PHASE_IDS;
        const float* SSQ = (const float*)(ws + WS_MODP);
        unsigned char* OAOB8 = ws + WS_U + 32 * MiB;
        const int gw2 = blockIdx.x * NWAVES + wave;
        for (int m = gw2; m < MTOK; m += G * NWAVES) {
            const int hh = lane >> 3;
            const float rstd = rsqrtf((SSQ[(size_t)m * 8 + hh] + SSQ[((size_t)MTOK + m) * 8 + hh]) * (1.f / 128.f) + 1e-6f);
            const u32x4* pp = (const u32x4*)(OAOB + (size_t)m * D + 1024 + 16 * lane);
            const u32x4 v0 = pp[0], v1 = pp[1];
            const float r4 = fminf(4.f * rstd, 3.0e38f);
#define P4B_C(x) fminf(fmaxf((x) * r4, -440.f), 440.f)
            u32x4 w;
            w.x = pk_fp8x4(P4B_C(bflo(v0.x)), P4B_C(bfhi(v0.x)), P4B_C(bflo(v0.y)), P4B_C(bfhi(v0.y))); w.y = pk_fp8x4(P4B_C(bflo(v0.z)), P4B_C(bfhi(v0.z)), P4B_C(bflo(v0.w)), P4B_C(bfhi(v0.w)));
            w.z = pk_fp8x4(P4B_C(bflo(v1.x)), P4B_C(bfhi(v1.x)), P4B_C(bflo(v1.y)), P4B_C(bfhi(v1.y))); w.w = pk_fp8x4(P4B_C(bflo(v1.z)), P4B_C(bfhi(v1.z)), P4B_C(bflo(v1.w)), P4B_C(bfhi(v1.w)));
#undef P4B_C
            *(u32x4*)(OAOB8 + (size_t)m * D + 1024 + 16 * lane) = w;
        }
    }
    xcd_barrier(bar);
    {
        pg8::StaticOrder S; S.init(ws + WS_U + 32 * MiB, WP, MTOK, D, D / 2, G, blockIdx.x, 8);
        pg8::EpiMerged E{HC, MERGED};
        pg8::gemm_phase<pg8::EpiMerged, pg8::StaticOrder, false, true, true>(lds, S, E, wave);
    }
    xcd_barrier(bar);
    {
        pg8::StaticOrder S; S.init(MERGED, WOUT, MTOK, D, D / 2, G, blockIdx.x, 8);
        pg8::EpiMixG E{MOD, OAOB, 1.f / 2048.f};
        pg8::gemm_phase<pg8::EpiMixG, pg8::StaticOrder, false, false, true>(lds, S, E, wave);
    }
    xcd_barrier(bar);

    {
        PHASE_IDS;
        LAS float* VEC = (LAS float*)lds;
        LAS float* PART = (LAS float*)(lds + 32768);
        LAS float* LOGIT = (LAS float*)(lds + 32768 + 98304);
        LAS int* CNTL = (LAS int*)(lds + 32768 + 98304 + 12288);
        for (int grp = blockIdx.x; grp < MTOK / 64; grp += G) {
            const int b = (grp * 64) / SEQ;
            __syncthreads();
            for (int i = tid; i < D; i += NTHREADS) { VEC[i] = a.in[I_LN1G][i]; VEC[D + i] = a.in[I_LN1B][i]; VEC[2 * D + i] = 1.f + MOD[(size_t)b * 6 * D + 4 * D + i]; VEC[3 * D + i] = MOD[(size_t)b * 6 * D + 3 * D + i]; }
            __syncthreads();
            const int r0 = grp * 64 + wave * 8;
            {
                f32x4 cur[8], nx[8]; u32x2 nm[8];
#define P7_LOADROW(m_) do { const f32x4* _xr = (const f32x4*)(x + (size_t)(m_) * D) + lane; const u32x2* _mr = (const u32x2*)(OAOB + (size_t)(m_) * D) + lane; \
                    _Pragma("unroll") for (int j = 0; j < 8; ++j) { nx[j] = _xr[64 * j]; nm[j] = _mr[64 * j]; } } while (0)
#define P7_TAKEROW() do { _Pragma("unroll") for (int j = 0; j < 8; ++j) cur[j] = nx[j] * ALPHA + (f32x4){bflo(nm[j].x), bfhi(nm[j].x), bflo(nm[j].y), bfhi(nm[j].y)}; } while (0)
                P7_LOADROW(r0); P7_TAKEROW();
#pragma unroll 1
                for (int rr = 0; rr < 8; ++rr) {
                    const int m = r0 + rr;
                    P7_LOADROW((rr + 1 < 8 ? m + 1 : m));
                    asm volatile("" ::: "memory");
                    u32x2* o = (u32x2*)((bf16*)(a.ws + WS_GDN) + (size_t)m * D) + lane;
                    ln_norm(cur, lane);
#pragma unroll
                    for (int j = 0; j < 8; ++j) { const f32x4 gg = *(const LAS f32x4*)(VEC + 4 * lane + 256 * j), bb = *(const LAS f32x4*)(VEC + D + 4 * lane + 256 * j); cur[j] = cur[j] * gg + bb; u32x2 w1; w1.x = pk2(cur[j][0], cur[j][1]); w1.y = pk2(cur[j][2], cur[j][3]); o[64 * j] = w1; }
                    ln_norm(cur, lane);
                    u32x2* uh = (u32x2*)(U + (size_t)m * D) + lane; u32x2* ul = (u32x2*)(ULO + (size_t)m * D) + lane;
#pragma unroll
                    for (int j = 0; j < 8; ++j) { const f32x4 sc = *(const LAS f32x4*)(VEC + 2 * D + 4 * lane + 256 * j), sh = *(const LAS f32x4*)(VEC + 3 * D + 4 * lane + 256 * j);
                        const f32x4 t = cur[j] * sc + sh;
                        u32x2 h; h.x = pk2(t[0], t[1]); h.y = pk2(t[2], t[3]);
                        u32x2 l; l.x = pk2(t[0] - bflo(h.x), t[1] - bfhi(h.x)); l.y = pk2(t[2] - bflo(h.y), t[3] - bfhi(h.y));
                        uh[64 * j] = h; ul[64 * j] = l; ((unsigned*)(a.ws + WS_MERGED + (size_t)m * D) + lane)[64 * j] = pk_fp8x4(t[0], t[1], t[2], t[3]); }
                    P7_TAKEROW();
                }
            }
#undef P7_TAKEROW
#undef P7_LOADROW
            VM_WAIT();
            __syncthreads();
            {
                const int fr = lane & 15, fq = lane >> 4;
                f32x4 cacc[4][3];
#pragma unroll
                for (int mt = 0; mt < 4; ++mt)
#pragma unroll
                    for (int nt = 0; nt < 3; ++nt) cacc[mt][nt] = (f32x4){0.f, 0.f, 0.f, 0.f};
                const size_t g0 = (size_t)grp * 64;
                const bf16* ah = U + (g0 + fr) * D + 256 * wave + 8 * fq; const bf16* al = ULO + (g0 + fr) * D + 256 * wave + 8 * fq;
                const bf16* bh = WRH + (size_t)fr * D + 256 * wave + 8 * fq; const bf16* bl = WRL + (size_t)fr * D + 256 * wave + 8 * fq;
#pragma unroll 2
                for (int sx = 0; sx < 8; ++sx) {
                    bf16x8 Ah[4], Al[4], Bh[3], Bl[3];
#pragma unroll
                    for (int mt = 0; mt < 4; ++mt) { Ah[mt] = *(const bf16x8*)(ah + (size_t)mt * 16 * D + 32 * sx); Al[mt] = *(const bf16x8*)(al + (size_t)mt * 16 * D + 32 * sx); }
#pragma unroll
                    for (int nt = 0; nt < 3; ++nt) { Bh[nt] = *(const bf16x8*)(bh + (size_t)nt * 16 * D + 32 * sx); Bl[nt] = *(const bf16x8*)(bl + (size_t)nt * 16 * D + 32 * sx); }
#pragma unroll
                    for (int mt = 0; mt < 4; ++mt)
#pragma unroll
                        for (int nt = 0; nt < 3; ++nt) {
                            cacc[mt][nt] = __builtin_amdgcn_mfma_f32_16x16x32_bf16(Ah[mt], Bh[nt], cacc[mt][nt], 0, 0, 0);
                            cacc[mt][nt] = __builtin_amdgcn_mfma_f32_16x16x32_bf16(Al[mt], Bh[nt], cacc[mt][nt], 0, 0, 0);
                            cacc[mt][nt] = __builtin_amdgcn_mfma_f32_16x16x32_bf16(Ah[mt], Bl[nt], cacc[mt][nt], 0, 0, 0);
                        }
                }
#pragma unroll
                for (int mt = 0; mt < 4; ++mt)
#pragma unroll
                    for (int nt = 0; nt < 3; ++nt)
#pragma unroll
                        for (int jx = 0; jx < 4; ++jx) PART[(wave * 64 + 16 * mt + 4 * fq + jx) * 48 + 16 * nt + fr] = cacc[mt][nt][jx];
            }
            if (tid < 64) CNTL[tid] = 0;
            __syncthreads();
            for (int idx = tid; idx < 64 * 48; idx += NTHREADS) { float sacc = 0.f;
#pragma unroll
                for (int w8 = 0; w8 < 8; ++w8) sacc += PART[w8 * 64 * 48 + idx];
                LOGIT[idx] = sacc; }
            __syncthreads();
            int e0 = 0, e1 = 0, rk0 = 0, rk1 = 0; float w0 = 0.f, w1 = 0.f;
            if (tid < 64) {
                const LAS float* lg = LOGIT + tid * 48;
                float gl[4]; float gmax = -3.0e38f; int gi = 0;
#pragma unroll
                for (int jx = 0; jx < 4; ++jx) { gl[jx] = lg[32 + jx] + a.in[I_BRG][jx]; if (gl[jx] > gmax) { gmax = gl[jx]; gi = jx; } }
                float gs = 0.f;
#pragma unroll
                for (int jx = 0; jx < 4; ++jx) gs += __expf(gl[jx] - gmax);
                const float pg = 1.f / gs;
                float el[8]; float emax = -3.0e38f; int i0 = 0;
#pragma unroll
                for (int jx = 0; jx < 8; ++jx) { el[jx] = lg[8 * gi + jx] + a.in[I_BRE][8 * gi + jx]; if (el[jx] > emax) { emax = el[jx]; i0 = jx; } }
                float e2 = -3.0e38f; int i1 = 0;
#pragma unroll
                for (int jx = 0; jx < 8; ++jx) { if (jx != i0 && el[jx] > e2) { e2 = el[jx]; i1 = jx; } }
                const float p1r = __expf(e2 - emax);
                const float t0 = 1.f / (1.f + p1r), t1 = p1r * t0;
                e0 = 8 * gi + i0; e1 = 8 * gi + i1; w0 = pg * t0; w1 = pg * t1;
                rk0 = __hip_atomic_fetch_add(CNTL + e0, 1, __ATOMIC_RELAXED, __HIP_MEMORY_SCOPE_WORKGROUP);
                rk1 = __hip_atomic_fetch_add(CNTL + e1, 1, __ATOMIC_RELAXED, __HIP_MEMORY_SCOPE_WORKGROUP);
            }
            __syncthreads();
            if (tid < 32) { const int cn = CNTL[tid]; CNTL[32 + tid] = cn ? (int)atomicAdd(CNT + 64 * tid, (unsigned)cn) : 0; }
            __syncthreads();
            if (tid < 64) {
                const int m = grp * 64 + tid, pos0 = CNTL[32 + e0] + rk0, pos1 = CNTL[32 + e1] + rk1;
                TOKLIST[(size_t)e0 * MTOK + pos0] = m; TOKLIST[(size_t)e1 * MTOK + pos1] = m;
                RI[m] = (i32x4){e0, pos0, e1, pos1}; RW[m] = (f32x2){w0, w1};
            }
        }
    }
    xcd_barrier(bar);

    volatile LAS int* TB = (volatile LAS int*)(LCTL + 16);
    if (wave == 0 && hw_lane() == 0) { int acc = 0; for (int e = 0; e < NEXP; ++e) { const int c = (int)__hip_atomic_load(CNT + 64 * e, __ATOMIC_RELAXED, __HIP_MEMORY_SCOPE_AGENT); TB[e] = acc; TB[33 + e] = c; acc += (c + 255) >> 8; } TB[32] = acc; }
    __syncthreads();

    {
        pg8::MoeOrder S; S.A = (const char*)(a.ws + WS_MERGED); S.Bt = (const char*)WGU; S.K = D / 2; S.b_estride = (size_t)1024 * D; S.toklist = TOKLIST; S.tb = TB; S.ncol = 4; S.G = G; S.c = blockIdx.x;
        pg8::EpiGateUp E{HB, 1.f / 64.f};
        pg8::gemm_phase<pg8::EpiGateUp, pg8::MoeOrder, true, false, true>(lds, S, E, wave);
    }
    xcd_barrier(bar);
    {
        pg8::MoeOrder S; S.A = (const char*)HB; S.Bt = (const char*)WD; S.K = EFF / 2; S.b_estride = (size_t)D * EFF; S.toklist = nullptr; S.tb = TB; S.ncol = 8; S.G = G; S.c = blockIdx.x;
        pg8::EpiBf16 E{(unsigned char*)YB, D, 64.f / 512.f};
        pg8::gemm_phase<pg8::EpiBf16, pg8::MoeOrder, false, false, true>(lds, S, E, wave);
    }
    xcd_barrier(bar);
    {
        PHASE_IDS;
        LAS float* VEC = (LAS float*)lds;
        for (int grp = blockIdx.x; grp < MTOK / 64; grp += G) {
            const int b = (grp * 64) / SEQ;
            __syncthreads();
            for (int i = tid; i < D; i += NTHREADS) { VEC[i] = a.in[I_LN2G][i]; VEC[D + i] = a.in[I_LN2B][i]; VEC[2 * D + i] = MOD[(size_t)b * 6 * D + 5 * D + i]; }
            __syncthreads();
            {
                const int mb = grp * 64 + wave * 8;
#define P10_ISSUE(ri_, m_, X_, Y0_, Y1_) do { const int _s0 = 256 * TB[(ri_).x] + (ri_).y, _s1 = 256 * TB[(ri_).z] + (ri_).w; \
                    const u32x2* _o = (const u32x2*)((const bf16*)(a.ws + WS_GDN) + (size_t)(m_) * D) + lane; const unsigned* _y0 = (const unsigned*)((const unsigned char*)YB + (size_t)_s0 * D) + lane; const unsigned* _y1 = (const unsigned*)((const unsigned char*)YB + (size_t)_s1 * D) + lane; \
                    _Pragma("unroll") for (int j = 0; j < 8; ++j) { X_[j] = _o[64 * j]; Y0_[j] = _y0[64 * j]; Y1_[j] = _y1[64 * j]; } } while (0)
                i32x4 riB = RI[mb + 1], riC; f32x2 rwA = RW[mb], rwB = RW[mb + 1], rwC;
                u32x2 cx[8], nx[8]; unsigned cy0[8], cy1[8], ny0[8], ny1[8];
                { const i32x4 riA = RI[mb]; P10_ISSUE(riA, mb, cx, cy0, cy1); }
#pragma unroll 1
                for (int rr = 0; rr < 8; ++rr) {
                    const int m = mb + rr, m1 = mb + (rr + 1 < 8 ? rr + 1 : 7), m2 = mb + (rr + 2 < 8 ? rr + 2 : 7);
                    riC = RI[m2]; rwC = RW[m2];
                    P10_ISSUE(riB, m1, nx, ny0, ny1);
                    asm volatile("" ::: "memory");
                    f32x4 v[8];
#pragma unroll
                    for (int j = 0; j < 8; ++j) {
                        const f32x2 p0 = __builtin_amdgcn_cvt_pk_f32_fp8(cy0[j], false), p1 = __builtin_amdgcn_cvt_pk_f32_fp8(cy0[j], true), q0 = __builtin_amdgcn_cvt_pk_f32_fp8(cy1[j], false), q1 = __builtin_amdgcn_cvt_pk_f32_fp8(cy1[j], true);
                        const float w0 = rwA.x * (1.f / 64.f), w1 = rwA.y * (1.f / 64.f);
                        const f32x4 f = {w0 * p0[0] + w1 * q0[0], w0 * p0[1] + w1 * q0[1], w0 * p1[0] + w1 * q1[0], w0 * p1[1] + w1 * q1[1]};
                        const f32x4 g2 = *(const LAS f32x4*)(VEC + 2 * D + 4 * lane + 256 * j);
                        v[j] = (f32x4){bflo(cx[j].x), bfhi(cx[j].x), bflo(cx[j].y), bfhi(cx[j].y)} * ALPHA + g2 * f;
                    }
                    ln_norm(v, lane);
                    f32x4* o = (f32x4*)(a.out + (size_t)m * D) + lane;
#pragma unroll
                    for (int j = 0; j < 8; ++j) { const f32x4 gg = *(const LAS f32x4*)(VEC + 4 * lane + 256 * j), bb = *(const LAS f32x4*)(VEC + D + 4 * lane + 256 * j); o[64 * j] = v[j] * gg + bb; }
#pragma unroll
                    for (int j = 0; j < 8; ++j) { cx[j] = nx[j]; cy0[j] = ny0[j]; cy1[j] = ny1[j]; }
                    rwA = rwB; riB = riC; rwB = rwC;
                }
#undef P10_ISSUE
            }
        }
    }
}

#undef MODP
#undef MOD
#undef WRH
#undef WRL
#undef WGU
#undef WD
#undef U
#undef ULO
#undef HB
#undef YB
#undef TOKLIST
#undef RI
#undef RW
#undef CNT
#undef WIN
#undef WP
#undef WOUT
#undef WBD
#undef BETA
#undef GG
#undef HC
#undef OAOB
#undef MERGED

extern "C" void kernel_launch(void* const* d_in, const int* in_sizes, int n_in, void* d_out, int out_size, void* d_ws, size_t ws_size, hipStream_t stream) {
    static int grid = 0;
    if (grid == 0) {
        int dev = 0, cus = 0, per_cu = 0;
        if (n_in != 23 || out_size != MTOK * D || ws_size < WS_END) { fprintf(stderr, "kernel_launch: unexpected shapes (n_in %d out %d ws %zu)\n", n_in, out_size, ws_size); grid = -1; return; }
        if (hipGetDevice(&dev) != hipSuccess || hipDeviceGetAttribute(&cus, hipDeviceAttributeMultiprocessorCount, dev) != hipSuccess) { grid = -1; return; }
        if (hipFuncSetAttribute((const void*)fwd, hipFuncAttributeMaxDynamicSharedMemorySize, LDS_BYTES) != hipSuccess) { fprintf(stderr, "hipFuncSetAttribute failed\n"); grid = -1; return; }
        if (hipOccupancyMaxActiveBlocksPerMultiprocessor(&per_cu, (const void*)fwd, NTHREADS, LDS_BYTES) != hipSuccess || per_cu < 1) fprintf(stderr, "occupancy query says %d\n", per_cu);
        (void)hipGetLastError();
        grid = cus;
    }
    if (grid < 0) return;
    (void)hipMemsetAsync((char*)d_ws + WS_CTL, 0, CTL_ZERO_BYTES, stream);
    Args a{};
    for (int i = 0; i < 23; ++i) a.in[i] = (const float*)d_in[i];
    a.out = (float*)d_out; a.ws = (unsigned char*)d_ws;
    hipLaunchKernelGGL(fwd, dim3(grid), dim3(NTHREADS), LDS_BYTES, stream, a);
}
```

```cpp
#include <hip/hip_runtime.h>
#include <cstdio>
#include <cstdint>

#define LAS __attribute__((address_space(3)))
typedef unsigned short bf16;
typedef short bf16x8 __attribute__((ext_vector_type(8)));
typedef float f32x4 __attribute__((ext_vector_type(4)));
typedef float f32x2 __attribute__((ext_vector_type(2)));
typedef float f32x16 __attribute__((ext_vector_type(16)));
typedef unsigned u32x4 __attribute__((ext_vector_type(4)));
typedef unsigned u32x2 __attribute__((ext_vector_type(2)));
typedef int i32x4 __attribute__((ext_vector_type(4)));
typedef __bf16 bf16x2_t __attribute__((ext_vector_type(2)));
typedef int i32x8 __attribute__((ext_vector_type(8)));

constexpr int NWAVES = 8, NTHREADS = 512;
constexpr int D = 2048, BATCH = 4, SEQ = 4096, MTOK = BATCH * SEQ;
constexpr int NEXP = 32, EFF = 512;
constexpr int IN_W = 9744, HC_W = 9728;
constexpr float LN_EPS = 1e-5f;
constexpr float ALPHA = 1.189207115002721f;
constexpr int MOE_ROWS = 40960;

constexpr size_t MiB = 1u << 20;
constexpr size_t WS_CTL = 0, CTL_ZERO_BYTES = 1 * MiB;
constexpr size_t WS_MODP = 1 * MiB;
constexpr size_t WS_MOD = 2 * MiB;
constexpr size_t WS_WBD = 2 * MiB + 256 * 1024;
constexpr size_t WS_WRH = 2 * MiB + 512 * 1024;
constexpr size_t WS_WRL = 2 * MiB + 768 * 1024;
constexpr size_t WS_RI = 3 * MiB;
constexpr size_t WS_RW = 3 * MiB + 512 * 1024;
constexpr size_t WS_TOKLIST = 4 * MiB;
constexpr size_t WS_BG = 6 * MiB;
constexpr size_t WS_WIN = 8 * MiB;
constexpr size_t WS_WP = 46 * MiB;
constexpr size_t WS_WOUT = 54 * MiB;
constexpr size_t WS_WGU = 62 * MiB;
constexpr size_t WS_WD = 190 * MiB;
constexpr size_t WS_U = 254 * MiB;
constexpr size_t WS_OAOB = 318 * MiB;
constexpr size_t WS_MERGED = 382 * MiB;
constexpr size_t WS_GDN = 446 * MiB;
constexpr size_t WS_HCAT = 590 * MiB;
constexpr size_t WS_H = WS_HCAT;
constexpr size_t WS_Y = WS_HCAT + 40 * MiB;
constexpr size_t WS_ULO = WS_HCAT + 200 * MiB;
constexpr size_t WS_END = 894 * MiB;
constexpr int CW_BAR = 4096;
constexpr int CW_CNT = 8192;

constexpr int SCRATCH_BYTES = 157696;
constexpr int LDSCTL_OFF = SCRATCH_BYTES;
constexpr int LDS_BYTES = SCRATCH_BYTES + 1024;

#define LDS_WAIT() asm volatile("s_waitcnt lgkmcnt(0)" ::: "memory")
#define VM_WAIT() asm volatile("s_waitcnt vmcnt(0)" ::: "memory")

__device__ __forceinline__ unsigned pk2(float lo, float hi) { bf16x2_t v; v.x = (__bf16)lo; v.y = (__bf16)hi; return __builtin_bit_cast(unsigned, v); }
__device__ __forceinline__ unsigned pk_fp8x4(float a, float b, float c, float d) { int w = 0; w = __builtin_amdgcn_cvt_pk_fp8_f32(a, b, w, false); w = __builtin_amdgcn_cvt_pk_fp8_f32(c, d, w, true); return (unsigned)w; }
__device__ __forceinline__ float bf2f(unsigned short b) { return __uint_as_float(((unsigned)b) << 16); }
__device__ __forceinline__ float bflo(unsigned w) { return __uint_as_float(w << 16); }
__device__ __forceinline__ float bfhi(unsigned w) { return __uint_as_float(w & 0xffff0000u); }
__device__ __forceinline__ float sigmoidf_(float x) { return __builtin_amdgcn_rcpf(1.f + __expf(-x)); }
__device__ __forceinline__ float siluf_(float x) { return x * __builtin_amdgcn_rcpf(1.f + __expf(-x)); }

__device__ __forceinline__ int hw_lane() { int l; asm volatile("v_mbcnt_lo_u32_b32 %0, -1, 0\n\tv_mbcnt_hi_u32_b32 %0, -1, %0" : "=v"(l)); return l; }
#define XB_TMO      128
#define XB_XCNT(j)  (256  + 64 * (j))
#define XB_XSUB(j)  (1280 + 64 * (j))
#define XB_XGEN(j)  (2304 + 64 * (j))
#define XB_TOP      3328
#define XB_TOPGEN   3392
#define XCD_BAR_WORDS 3456
#define XB_SPIN_CAP (1u << 18)

__device__ __forceinline__ unsigned xb_ld(unsigned* p)              { return __hip_atomic_load(p, __ATOMIC_RELAXED, __HIP_MEMORY_SCOPE_AGENT); }
__device__ __forceinline__ unsigned xb_add(unsigned* p, unsigned v) { return __hip_atomic_fetch_add(p, v, __ATOMIC_RELAXED, __HIP_MEMORY_SCOPE_AGENT); }
__device__ __forceinline__ unsigned xb_xcc_id() { return (unsigned)__builtin_amdgcn_s_getreg((3 << 11) | 20) & 0xFu; }
#define XB_SPIN(cond, bar) do { unsigned _sp = 0; while (cond) { __builtin_amdgcn_s_sleep(1); \
    if ((++_sp & 255u) == 0u) { if (xb_ld(&(bar)[XB_TMO])) break; if (_sp > XB_SPIN_CAP) { atomicAdd(&(bar)[XB_TMO], 1u); break; } } } } while (0)

struct XcdBarrier { unsigned* bar; unsigned x; volatile LAS unsigned* st; bool wave0; };

__device__ __forceinline__ XcdBarrier xcd_barrier_post(unsigned* bar, volatile LAS unsigned* st, bool wave0) {
    XcdBarrier b; b.bar = bar; b.x = xb_xcc_id(); b.st = st; b.wave0 = wave0;
    if (wave0 && hw_lane() == 0) (void)xb_add(&bar[XB_XCNT(b.x)], 1u);
    return b;
}
__device__ __forceinline__ void xcd_barrier_complete(unsigned* bar, unsigned x, unsigned& nloc, unsigned& nx) {
    const unsigned G = gridDim.x * gridDim.y * gridDim.z;
    unsigned sum, cnt, mine, sp = 0u;
    for (;;) {
        sum = 0u; cnt = 0u; mine = 0u;
#pragma unroll
        for (unsigned j = 0; j < 16; ++j) { const unsigned c = xb_ld(&bar[XB_XCNT(j)]); sum += c; cnt += (c > 0u) ? 1u : 0u; mine = (j == x) ? c : mine; }
        if (sum == G) break;
        __builtin_amdgcn_s_sleep(1);
        if ((++sp & 255u) == 0u) { if (xb_ld(&bar[XB_TMO])) break; if (sp > XB_SPIN_CAP) { atomicAdd(&bar[XB_TMO], 1u); break; } }
    }
    nloc = mine > 0u ? mine : 1u; nx = cnt > 0u ? cnt : 1u;
}
__device__ __forceinline__ void xcd_barrier(const XcdBarrier& b) {
    asm volatile("s_waitcnt vmcnt(0)" ::: "memory");
    __syncthreads();
    if (b.wave0 && hw_lane() == 0) {
        unsigned* bar = b.bar;
        __builtin_amdgcn_s_waitcnt(0);
        unsigned nloc = b.st[0], nx = b.st[1];
        if (nloc == 0u) { xcd_barrier_complete(bar, b.x, nloc, nx); b.st[0] = nloc; b.st[1] = nx; }
        const unsigned old = xb_add(&bar[XB_XSUB(b.x)], 1u);
        const unsigned gen = old / nloc;
        if (old + 1u == (gen + 1u) * nloc) {
            __builtin_amdgcn_fence(__ATOMIC_RELEASE, "agent");
            asm volatile("s_waitcnt vmcnt(0)" ::: "memory");
            const unsigned og = xb_add(&bar[XB_TOP], 1u);
            const unsigned tg = og / nx;
            if (og + 1u == (tg + 1u) * nx) xb_add(&bar[XB_TOPGEN], 1u);
            else XB_SPIN(xb_ld(&bar[XB_TOPGEN]) == tg, bar);
            __builtin_amdgcn_fence(__ATOMIC_ACQUIRE, "agent");
            xb_add(&bar[XB_XGEN(b.x)], 1u);
            asm volatile("s_waitcnt vmcnt(0)" ::: "memory");
        } else {
            XB_SPIN(xb_ld(&bar[XB_XGEN(b.x)]) == gen, bar);
            __builtin_amdgcn_fence(__ATOMIC_ACQUIRE, "agent");
            asm volatile("s_waitcnt vmcnt(0)" ::: "memory");
        }
    }
    __syncthreads();
}

namespace pg8 {
constexpr int BM = 256, BK = 64, HALF = 128, HTB = HALF * BK * 2, STAGE_BYTES = 8 * HTB, NXCD = 8, WGM = 2;
__host__ __device__ __forceinline__ int lds_byte(int r, int c) { const int st = (r >> 4) * 2 + (c >> 5), rr = r & 15, cc = c & 31, ob = rr * 64 + cc * 2; return st * 1024 + (ob ^ (((ob >> 9) & 1) << 5)); }
__host__ __device__ __forceinline__ void stage_rc(int b, int& R, int& C) { const int st = b / 1024, sb = b % 1024, swz = sb ^ (((sb >> 9) & 1) << 5); R = (st >> 1) * 16 + swz / 64; C = (st & 1) * 32 + (swz % 64) / 2; }
__host__ __device__ __forceinline__ int perm32(int rho) { const int n = rho >> 4, i = rho & 15; return 8 * (i >> 2) + 4 * n + (i & 3); }

struct Unit { int pm, pn, e, r0, nrows; };

struct StaticOrder {
    const char* A; const char* Bt; int K;
    int nM, nN, nwg, G, c, wgm;
    __device__ void init(const void* A_, const void* Bt_, int M, int N, int K_, int G_, int c_, int wgm_ = WGM) { A = (const char*)A_; Bt = (const char*)Bt_; K = K_; nM = M / BM; nN = N / BM; nwg = nM * nN; G = G_; c = c_; wgm = wgm_; }
    __device__ bool next(int i, Unit& u) const {
        const long L = (long)i * G + c; if (L >= nwg) return false;
        int wgid = (int)L; { const int q = nwg / NXCD, r = nwg % NXCD, xcd = wgid % NXCD, off = wgid / NXCD; wgid = (xcd < r ? xcd * (q + 1) : r * (q + 1) + (xcd - r) * q) + off; }
        const int nig = wgm * nN, gid = wgid / nig, fm = gid * wgm, gsz = (nM - fm) < wgm ? (nM - fm) : wgm;
        u.pm = fm + ((wgid % nig) % gsz); u.pn = (wgid % nig) / gsz; u.e = 0; u.r0 = 0; u.nrows = BM; return true;
    }
    __device__ __forceinline__ const char* a_base(const Unit& u) const { return A + (size_t)u.pm * (size_t)BM * K * 2; }
    __device__ __forceinline__ const char* b_base(const Unit& u) const { return Bt + (size_t)u.pn * (size_t)BM * K * 2; }
    __device__ __forceinline__ void a_rows(const Unit&, int, LAS unsigned*) const {}
};

struct MoeOrder {
    const char* A; const char* Bt; int K; size_t b_estride;
    const int* toklist; const volatile LAS int* tb; int ncol, G, c;
    __device__ bool next(int i, Unit& u) const {
        const int L0 = i * G + c, total = __builtin_amdgcn_readfirstlane(tb[32]) * ncol; if (L0 >= total) return false;
        int L; { const int q = total / NXCD, r = total % NXCD, xcd = L0 % NXCD, off = L0 / NXCD; L = (xcd < r ? xcd * (q + 1) : r * (q + 1) + (xcd - r) * q) + off; }
        const int rt = L / ncol; u.pn = L - rt * ncol; u.pm = rt;
        int e = 0;
        for (int j = 1; j < 32; ++j) e = (tb[j] <= rt) ? j : e;
        u.e = e; u.r0 = (rt - tb[e]) * BM; const int left = tb[33 + e] - u.r0; u.nrows = left < BM ? left : BM;
        u.pm = __builtin_amdgcn_readfirstlane(u.pm); u.pn = __builtin_amdgcn_readfirstlane(u.pn); u.e = __builtin_amdgcn_readfirstlane(u.e); u.r0 = __builtin_amdgcn_readfirstlane(u.r0); u.nrows = __builtin_amdgcn_readfirstlane(u.nrows);
        return true;
    }
    __device__ __forceinline__ const char* a_base(const Unit& u) const { return toklist ? A : A + (size_t)u.pm * (size_t)BM * K * 2; }
    __device__ __forceinline__ const char* b_base(const Unit& u) const { return Bt + (size_t)u.e * b_estride + (size_t)u.pn * (size_t)BM * K * 2; }
    __device__ __forceinline__ void a_rows(const Unit& u, int tid, LAS unsigned* dst) const {
#pragma unroll
        for (int h = 0; h < 2; ++h)
#pragma unroll
            for (int i = 0; i < 2; ++i) { int R, C; stage_rc(tid * 16 + i * 8192, R, C); int r = h * HALF + R; r = r < u.nrows ? r : u.nrows - 1;
                const int tok = toklist[(size_t)u.e * MTOK + u.r0 + r]; dst[(h * 2 + i) * 512] = ((unsigned)tok * (unsigned)K + (unsigned)C) * 2u; }
    }
};

__device__ __forceinline__ void glds16(const char* sbase, unsigned voff, unsigned lds_dst) {
    unsigned keep;
    asm volatile("s_mov_b32 %0, m0\n\ts_mov_b32 m0, %3\n\ts_nop 0\n\tglobal_load_lds_dwordx4 %1, %2\n\ts_mov_b32 m0, %0" : "=&s"(keep) : "v"(voff), "s"(sbase), "s"(lds_dst) : "memory");
}
__device__ __forceinline__ const char* uniform_ptr(const char* p) { const unsigned long long v = (unsigned long long)p; const unsigned lo = __builtin_amdgcn_readfirstlane((unsigned)v), hi = __builtin_amdgcn_readfirstlane((unsigned)(v >> 32)); return (const char*)(((unsigned long long)hi << 32) | lo); }
template <class Epi, class Sched, bool GATHER, bool MIDK, bool FP8 = false>
__device__ __forceinline__ void gemm_phase(LAS unsigned char* lds, const Sched& S, const Epi& E, int wid) {
    int lane = hw_lane(); asm volatile("" : "+v"(lane));
    const int tid = wid * 64 + lane, wr = wid >> 2, wc = wid & 3, fr = lane & 15, fq = lane >> 4;
    const int K = S.K, nt = K / BK;
    unsigned voffA[2], voffB[2];
#pragma unroll
    for (int i = 0; i < 2; ++i) { int R, C; stage_rc(tid * 16 + i * 8192, R, C); const int Rb = Epi::PERM ? ((R & ~31) + perm32(R & 31)) : R;
        voffA[i] = (unsigned)(R * K + C) * 2u; voffB[i] = (unsigned)(Rb * K + C) * 2u; }
    const size_t kstep = (size_t)(BK * 2);
    const size_t hstep = (size_t)HALF * K * 2;
    const unsigned ldsw = (unsigned)wid * 1024u;
    const int aoff = lds_byte(wr * 64 + fr, fq * 8), boff = lds_byte(wc * 32 + fr, fq * 8);
    LAS unsigned* gofs = (LAS unsigned*)(lds + STAGE_BYTES) + tid;
    int par = 0;
#define PG8_SA(b, h) (((b) * 2 + (h)) * HTB)
#define PG8_SB(b, h) ((4 + (b) * 2 + (h)) * HTB)
    const unsigned ldsbase = (unsigned)(unsigned long long)lds + ldsw;
#define PG8_STAGE(bufoff, gbase, voff) do { const char* _gb = uniform_ptr((const char*)(gbase)); _Pragma("unroll") for (int _i = 0; _i < 2; ++_i) glds16(_gb, (voff)[_i], ldsbase + (bufoff) + _i * 8192); } while (0)
#define PG8_STAGE_A(bufoff, kbase, h, nx) do { if constexpr (GATHER) { const char* _gb = uniform_ptr((const char*)(kbase)); _Pragma("unroll") for (int _i = 0; _i < 2; ++_i) { const unsigned _o = gofs[((((nx) ? par ^ 1 : par) * 4) + (h) * 2 + _i) * 512]; \
        glds16(_gb, _o, ldsbase + (bufoff) + _i * 8192); } } \
        else { PG8_STAGE(bufoff, (const char*)(kbase) + ((h) ? hstep : (size_t)0), voffA); } } while (0)
    const LAS unsigned char* ldsA = lds + aoff; const LAS unsigned char* ldsB = lds + 4 * HTB + boff;
#define PG8_LD8(ptr, imm) __builtin_shufflevector(*(const LAS i32x4*)((ptr) + (imm)), *(const LAS i32x4*)((ptr) + (imm) + 1024), 0, 1, 2, 3, 4, 5, 6, 7)
#define PG8_LDA(dst, b, h) do { _Pragma("unroll") for (int m = 0; m < 4; ++m) dst[m] = PG8_LD8(ldsA, ((b) * 2 + (h)) * HTB + m * 2048); } while (0)
#define PG8_LDB(dst, b, h) do { _Pragma("unroll") for (int n = 0; n < 2; ++n) dst[n] = PG8_LD8(ldsB, ((b) * 2 + (h)) * HTB + n * 2048); } while (0)
#define PG8_LO(v) __builtin_bit_cast(bf16x8, __builtin_shufflevector(v, v, 0, 1, 2, 3))
#define PG8_HI(v) __builtin_bit_cast(bf16x8, __builtin_shufflevector(v, v, 4, 5, 6, 7))
#define PG8_MMA(ai, bj, At, Bt) do { __builtin_amdgcn_s_setprio(1); if constexpr (FP8) { _Pragma("unroll") for (int m = 0; m < 4; ++m) _Pragma("unroll") for (int n = 0; n < 2; ++n) \
        acc[ai][bj][m][n] = __builtin_amdgcn_mfma_scale_f32_16x16x128_f8f6f4(Bt[n], At[m], acc[ai][bj][m][n], 0, 0, 0, 0x7f7f7f7f, 0, 0x7f7f7f7f); } \
        else { _Pragma("unroll") for (int m = 0; m < 4; ++m) _Pragma("unroll") for (int n = 0; n < 2; ++n) { \
        acc[ai][bj][m][n] = __builtin_amdgcn_mfma_f32_16x16x32_bf16(PG8_LO(Bt[n]), PG8_LO(At[m]), acc[ai][bj][m][n], 0, 0, 0); \
        acc[ai][bj][m][n] = __builtin_amdgcn_mfma_f32_16x16x32_bf16(PG8_HI(Bt[n]), PG8_HI(At[m]), acc[ai][bj][m][n], 0, 0, 0); } } __builtin_amdgcn_s_setprio(0); } while (0)
#define PG8_WAIT_V(n) asm volatile("s_waitcnt vmcnt(" #n ")" ::: "memory")
#define PG8_WAIT_L(n) asm volatile("s_waitcnt lgkmcnt(" #n ")" ::: "memory")
#define PG8_BAR __builtin_amdgcn_s_barrier()
#define PG8_SCHED __builtin_amdgcn_sched_barrier(0)
    Unit cur, nxt; int ui = 0;
    if (!S.next(0, cur)) return;
    f32x4 acc[2][2][4][2];
#pragma unroll
    for (int a = 0; a < 2; ++a)
#pragma unroll
        for (int b = 0; b < 2; ++b)
#pragma unroll
            for (int m = 0; m < 4; ++m)
#pragma unroll
                for (int n = 0; n < 2; ++n) acc[a][b][m][n] = (f32x4){0.f, 0.f, 0.f, 0.f};
    i32x8 At[4], B0[2], B1[2];
    const char* cA = S.a_base(cur); const char* cB = S.b_base(cur);
    if constexpr (GATHER) S.a_rows(cur, tid, gofs);
    PG8_STAGE(PG8_SB(0, 0), cB, voffB); PG8_STAGE(PG8_SB(0, 1), cB + hstep, voffB); PG8_STAGE_A(PG8_SA(0, 0), cA, 0, false); PG8_STAGE_A(PG8_SA(0, 1), cA, 1, false);
    if (wr == 1) PG8_BAR;
    PG8_WAIT_V(2); PG8_BAR;
    PG8_STAGE(PG8_SB(1, 0), cB + kstep, voffB); PG8_STAGE_A(PG8_SA(1, 0), cA + kstep, 0, false); PG8_STAGE(PG8_SB(1, 1), cB + hstep + kstep, voffB);
    PG8_WAIT_V(6); PG8_BAR;
    for (;;) {
        const bool has_next = S.next(ui + 1, nxt);
        const char* nA = has_next ? S.a_base(nxt) : cA; const char* nB = has_next ? S.b_base(nxt) : cB;
        if constexpr (GATHER) S.a_rows(has_next ? nxt : cur, tid, gofs + (par ^ 1) * 4 * 512);
        for (int tb0 = 0; tb0 < nt; tb0 += (MIDK ? nt / 2 : nt)) {
        if constexpr (MIDK) { if (tb0 != 0) E.mid(acc, cur, wr, wc, fr, fq); }
        const int tend = tb0 + (MIDK ? nt / 2 : nt);
        for (int t = tb0; t < tend; t += 2) {
            const bool last = (t == nt - 2);
            const char* a1 = cA + (size_t)(t + 1) * kstep;
            const char* a2 = last ? nA : cA + (size_t)(t + 2) * kstep; const char* b2 = last ? nB : cB + (size_t)(t + 2) * kstep;
            const char* a3 = a2 + kstep; const char* b3 = b2 + kstep;
            PG8_LDB(B0, 0, 0); PG8_LDB(B1, 0, 1); PG8_SCHED; PG8_LDA(At, 0, 0); PG8_STAGE_A(PG8_SA(1, 1), a1, 1, false);
            PG8_WAIT_V(8); PG8_WAIT_L(0); PG8_BAR; PG8_MMA(0, 0, At, B0); PG8_MMA(0, 1, At, B1); PG8_BAR; PG8_SCHED;
            PG8_LDA(At, 0, 1); PG8_STAGE(PG8_SB(0, 0), b2, voffB); PG8_STAGE(PG8_SB(0, 1), b2 + hstep, voffB); PG8_STAGE_A(PG8_SA(0, 0), a2, 0, last);
            PG8_WAIT_V(8); PG8_WAIT_L(0); PG8_BAR; PG8_MMA(1, 0, At, B0); PG8_MMA(1, 1, At, B1); PG8_BAR; PG8_SCHED;
            PG8_LDB(B0, 1, 0); PG8_LDB(B1, 1, 1); PG8_SCHED; PG8_LDA(At, 1, 0); PG8_STAGE_A(PG8_SA(0, 1), a2, 1, last);
            PG8_WAIT_V(8); PG8_WAIT_L(0); PG8_BAR; PG8_MMA(0, 0, At, B0); PG8_MMA(0, 1, At, B1); PG8_BAR; PG8_SCHED;
            PG8_LDA(At, 1, 1); PG8_STAGE(PG8_SB(1, 0), b3, voffB); PG8_STAGE(PG8_SB(1, 1), b3 + hstep, voffB); PG8_STAGE_A(PG8_SA(1, 0), a3, 0, last);
            PG8_WAIT_V(8); PG8_WAIT_L(0); PG8_BAR; PG8_MMA(1, 0, At, B0); PG8_MMA(1, 1, At, B1); PG8_BAR; PG8_SCHED;
        }
        }
        if (wr == 0) PG8_BAR;
        E(acc, cur, wr, wc, fr, fq);
        if (!has_next) break;
#pragma unroll
        for (int a = 0; a < 2; ++a)
#pragma unroll
            for (int b = 0; b < 2; ++b)
#pragma unroll
                for (int m = 0; m < 4; ++m)
#pragma unroll
                    for (int n = 0; n < 2; ++n) acc[a][b][m][n] = (f32x4){0.f, 0.f, 0.f, 0.f};
        cur = nxt; cA = nA; cB = nB; ++ui;
        if constexpr (GATHER) par ^= 1;
        if (wr == 1) PG8_BAR;
    }
    PG8_WAIT_V(0);
    PG8_BAR;
#undef PG8_SA
#undef PG8_SB
#undef PG8_STAGE
#undef PG8_STAGE_A
#undef PG8_LDA
#undef PG8_LDB
#undef PG8_MMA
#undef PG8_LD8
#undef PG8_LO
#undef PG8_HI
#undef PG8_WAIT_V
#undef PG8_WAIT_L
#undef PG8_BAR
#undef PG8_SCHED
}

struct EpiGateUp {
    static constexpr bool PERM = true;
    bf16* H; float sc;
    __device__ __forceinline__ void operator()(const f32x4 (&acc)[2][2][4][2], const Unit& u, int wr, int wc, int, int) const {
        const int hl = hw_lane(); int frq = hl & 15; asm volatile("" : "+v"(frq)); int fqq = hl >> 4; asm volatile("" : "+v"(fqq));
        const int row0 = u.pm * BM + wr * 64 + frq, col0 = u.pn * HALF + wc * 32 + 8 * fqq;
#pragma unroll
        for (int ai = 0; ai < 2; ++ai)
#pragma unroll
            for (int m = 0; m < 4; ++m) {
                unsigned char* rowp = (unsigned char*)H + (size_t)(row0 + ai * HALF + m * 16) * EFF + col0;
                const f32x4 g0 = acc[ai][0][m][0] * sc, g1 = acc[ai][0][m][1] * sc, u0 = acc[ai][1][m][0] * (8.f * sc), u1 = acc[ai][1][m][1] * (8.f * sc);
#define EGU_C(x) fminf(fmaxf((x), -440.f), 440.f)
                u32x2 w;
                w.x = pk_fp8x4(EGU_C(siluf_(g0[0]) * u0[0]), EGU_C(siluf_(g0[1]) * u0[1]), EGU_C(siluf_(g0[2]) * u0[2]), EGU_C(siluf_(g0[3]) * u0[3]));
                w.y = pk_fp8x4(EGU_C(siluf_(g1[0]) * u1[0]), EGU_C(siluf_(g1[1]) * u1[1]), EGU_C(siluf_(g1[2]) * u1[2]), EGU_C(siluf_(g1[3]) * u1[3]));
#undef EGU_C
                *(u32x2*)rowp = w;
            }
    }
};
struct EpiBf16 {
    static constexpr bool PERM = true;
    unsigned char* O; int ldc; float sc;
    __device__ __forceinline__ void operator()(const f32x4 (&acc)[2][2][4][2], const Unit& u, int wr, int wc, int fr, int fq) const {
        int frq = fr; asm volatile("" : "+v"(frq)); int fqq = fq; asm volatile("" : "+v"(fqq));
        const int row0 = u.pm * BM + wr * 64 + frq, col0 = u.pn * BM + wc * 32 + 8 * fqq;
#define EY_C(x) fminf(fmaxf((x) * sc, -440.f), 440.f)
#pragma unroll
        for (int ai = 0; ai < 2; ++ai)
#pragma unroll
            for (int m = 0; m < 4; ++m) {
                unsigned char* rowp = O + (size_t)(row0 + ai * HALF + m * 16) * ldc + col0;
#pragma unroll
                for (int bj = 0; bj < 2; ++bj) { const f32x4 v0 = acc[ai][bj][m][0], v1 = acc[ai][bj][m][1];
                    u32x2 w; w.x = pk_fp8x4(EY_C(v0[0]), EY_C(v0[1]), EY_C(v0[2]), EY_C(v0[3])); w.y = pk_fp8x4(EY_C(v1[0]), EY_C(v1[1]), EY_C(v1[2]), EY_C(v1[3]));
                    *(u32x2*)(rowp + bj * HALF) = w; }
            }
#undef EY_C
    }
};

struct EpiHcat {
    static constexpr bool PERM = true;
    bf16* O; float sc;
    __device__ __forceinline__ void operator()(const f32x4 (&acc)[2][2][4][2], const Unit& u, int wr, int wc, int, int) const {
        const int hl = hw_lane(); int frq = hl & 15; asm volatile("" : "+v"(frq)); int fqq = hl >> 4; asm volatile("" : "+v"(fqq));
        const int row0 = u.pm * BM + wr * 64 + frq;
        const int kind = u.pn < 4 ? 0 : (u.pn < 18 ? 1 : (u.pn < 22 ? 2 : 3));
        if (kind == 3) {
            const int c0 = 128 * (u.pn - 22) + wc * 32 + 8 * fqq;
#pragma unroll
            for (int ai = 0; ai < 2; ++ai)
#pragma unroll
                for (int m = 0; m < 4; ++m) {
                    bf16* rowp = O + (size_t)(row0 + ai * HALF + m * 16) * HC_W + 5632 + c0;
                    float rho[8], sb[8];
#pragma unroll
                    for (int n = 0; n < 2; ++n)
#pragma unroll
                        for (int j = 0; j < 4; ++j) { const float pa = 1.f + __expf(fminf(-acc[ai][0][m][n][j] * sc, 40.f)), pb = 1.f + __expf(fminf(-acc[ai][1][m][n][j] * sc, 40.f));
                            const float r = __builtin_amdgcn_rcpf(pa * pb);
                            sb[4 * n + j] = r * pa; rho[4 * n + j] = (pb * pb) * r; }
                    u32x4 w; w.x = pk2(rho[0], rho[1]); w.y = pk2(rho[2], rho[3]); w.z = pk2(rho[4], rho[5]); w.w = pk2(rho[6], rho[7]);
                    *(u32x4*)rowp = w;
                    w.x = pk2(sb[0], sb[1]); w.y = pk2(sb[2], sb[3]); w.z = pk2(sb[4], sb[5]); w.w = pk2(sb[6], sb[7]);
                    *(u32x4*)(rowp + 2048) = w;
                }
            return;
        }
        const int col0 = u.pn * BM + wc * 32 + 8 * fqq;
#pragma unroll
        for (int ai = 0; ai < 2; ++ai)
#pragma unroll
            for (int m = 0; m < 4; ++m) {
                bf16* rowp = O + (size_t)(row0 + ai * HALF + m * 16) * HC_W + col0;
#pragma unroll
                for (int bj = 0; bj < 2; ++bj) { f32x4 v0 = acc[ai][bj][m][0] * sc, v1 = acc[ai][bj][m][1] * sc;
                    if (kind == 0) { v0 = v0 * 0.125f; v1 = v1 * 0.125f; }
                    else if (kind == 2) {
#pragma unroll
                        for (int j = 0; j < 4; ++j) { v0[j] = siluf_(v0[j]); v1[j] = siluf_(v1[j]); } }
                    u32x4 w; w.x = pk2(v0[0], v0[1]); w.y = pk2(v0[2], v0[3]); w.z = pk2(v1[0], v1[1]); w.w = pk2(v1[2], v1[3]);
                    *(u32x4*)(rowp + bj * HALF) = w; }
            }
    }
};
struct EpiMerged {
    static constexpr bool PERM = true;
    const bf16* HC; bf16* O;
    __device__ __forceinline__ void mid(f32x4 (&acc)[2][2][4][2], const Unit& u, int wr, int wc, int fr, int fq) const {
        int frq = fr; asm volatile("" : "+v"(frq)); int fqq = fq; asm volatile("" : "+v"(fqq));
        const int row0 = u.pm * BM + wr * 64 + frq, col0 = u.pn * BM + wc * 32 + 8 * fqq;
#pragma unroll
        for (int ai = 0; ai < 2; ++ai) {
            u32x4 rh[4][2];
#pragma unroll
            for (int m = 0; m < 4; ++m)
#pragma unroll
                for (int bj = 0; bj < 2; ++bj) rh[m][bj] = *(const u32x4*)(HC + (size_t)(row0 + ai * HALF + m * 16) * HC_W + col0 + bj * HALF + 5632);
#pragma unroll
            for (int m = 0; m < 4; ++m)
#pragma unroll
                for (int bj = 0; bj < 2; ++bj) { const u32x4 a4 = rh[m][bj];
                    const f32x4 r0 = {bflo(a4.x), bfhi(a4.x), bflo(a4.y), bfhi(a4.y)}, r1 = {bflo(a4.z), bfhi(a4.z), bflo(a4.w), bfhi(a4.w)};
                    acc[ai][bj][m][0] = acc[ai][bj][m][0] * r0; acc[ai][bj][m][1] = acc[ai][bj][m][1] * r1; }
            asm volatile("" : "+v"(acc[ai][0][0][0]), "+v"(acc[ai][1][3][1]) :: "memory");
        }
    }
    __device__ __forceinline__ void operator()(const f32x4 (&acc)[2][2][4][2], const Unit& u, int wr, int wc, int fr, int fq) const {
        int frq = fr; asm volatile("" : "+v"(frq)); int fqq = fq; asm volatile("" : "+v"(fqq));
        const int row0 = u.pm * BM + wr * 64 + frq, col0 = u.pn * BM + wc * 32 + 8 * fqq;
#pragma unroll
        for (int ai = 0; ai < 2; ++ai) {
            u32x4 sb[4][2];
#pragma unroll
            for (int m = 0; m < 4; ++m)
#pragma unroll
                for (int bj = 0; bj < 2; ++bj) sb[m][bj] = *(const u32x4*)(HC + (size_t)(row0 + ai * HALF + m * 16) * HC_W + col0 + 7680 + bj * HALF);
#pragma unroll
            for (int m = 0; m < 4; ++m)
#pragma unroll
                for (int bj = 0; bj < 2; ++bj) { const u32x4 b4 = sb[m][bj];
                    const f32x4 v0 = acc[ai][bj][m][0], v1 = acc[ai][bj][m][1];
                    u32x2 w;
                    w.x = pk_fp8x4(0.125f * v0[0] * fmaxf(bflo(b4.x), 1e-20f), 0.125f * v0[1] * fmaxf(bfhi(b4.x), 1e-20f), 0.125f * v0[2] * fmaxf(bflo(b4.y), 1e-20f), 0.125f * v0[3] * fmaxf(bfhi(b4.y), 1e-20f));
                    w.y = pk_fp8x4(0.125f * v1[0] * fmaxf(bflo(b4.z), 1e-20f), 0.125f * v1[1] * fmaxf(bfhi(b4.z), 1e-20f), 0.125f * v1[2] * fmaxf(bflo(b4.w), 1e-20f), 0.125f * v1[3] * fmaxf(bfhi(b4.w), 1e-20f));
                    *(u32x2*)((unsigned char*)O + (size_t)(row0 + ai * HALF + m * 16) * D + col0 + bj * HALF) = w; }
            asm volatile("" ::: "memory");
        }
    }
};
struct EpiMixG {
    static constexpr bool PERM = true;
    const float* MODv; bf16* O; float sc;
    __device__ __forceinline__ void operator()(const f32x4 (&acc)[2][2][4][2], const Unit& u, int wr, int wc, int fr, int fq) const {
        int frq = fr; asm volatile("" : "+v"(frq)); int fqq = fq; asm volatile("" : "+v"(fqq));
        const int row0 = u.pm * BM + wr * 64 + frq, col0 = u.pn * BM + wc * 32 + 8 * fqq;
        const float* g1 = MODv + (size_t)((u.pm * BM) / SEQ) * 6 * D + 2 * D;
        f32x4 gv[2][2];
#pragma unroll
        for (int bj = 0; bj < 2; ++bj)
#pragma unroll
            for (int n = 0; n < 2; ++n) gv[bj][n] = *(const f32x4*)(g1 + col0 + bj * HALF + 4 * n) * sc;
#pragma unroll
        for (int ai = 0; ai < 2; ++ai)
#pragma unroll
            for (int m = 0; m < 4; ++m) {
                bf16* rowp = O + (size_t)(row0 + ai * HALF + m * 16) * D + col0;
#pragma unroll
                for (int bj = 0; bj < 2; ++bj) { const f32x4 v0 = acc[ai][bj][m][0] * gv[bj][0], v1 = acc[ai][bj][m][1] * gv[bj][1];
                    u32x4 w; w.x = pk2(v0[0], v0[1]); w.y = pk2(v0[2], v0[3]); w.z = pk2(v1[0], v1[1]); w.w = pk2(v1[2], v1[3]);
                    *(u32x4*)(rowp + bj * HALF) = w; }
            }
    }
};
}

__device__ __forceinline__ float shx(float v, int o, int lane) { return __int_as_float(__builtin_amdgcn_ds_bpermute((lane ^ o) << 2, __float_as_int(v))); }
__device__ __forceinline__ float shl_(float v, int src_lane) { return __int_as_float(__builtin_amdgcn_ds_bpermute(src_lane << 2, __float_as_int(v))); }
__device__ __forceinline__ float wave_sum(float v, int lane) {
#pragma unroll
    for (int o = 1; o < 64; o <<= 1) v += shx(v, o, lane);
    return v;
}

struct Args { const float* in[23]; float* out; unsigned char* ws; };
enum { I_X = 0, I_C, I_WADA, I_BADA, I_WIN, I_CONVW, I_SINKS, I_ALOG, I_DTB, I_NORMW, I_WPA, I_WPB, I_WOUT, I_LN1G, I_LN1B, I_WRG, I_BRG, I_WRE, I_BRE, I_WGU, I_WDN, I_LN2G, I_LN2B };

__device__ __forceinline__ void ln_norm(f32x4 (&v)[8], int lane) {
    float s = 0.f;
#pragma unroll
    for (int j = 0; j < 8; ++j) s += (v[j].x + v[j].y) + (v[j].z + v[j].w);
    const float mean = wave_sum(s, lane) * (1.f / D);
    float s2 = 0.f;
#pragma unroll
    for (int j = 0; j < 8; ++j) { v[j] = v[j] - mean; s2 += (v[j].x * v[j].x + v[j].y * v[j].y) + (v[j].z * v[j].z + v[j].w * v[j].w); }
    const float rstd = 1.f / sqrtf(wave_sum(s2, lane) * (1.f / D) + LN_EPS);
#pragma unroll
    for (int j = 0; j < 8; ++j) v[j] = v[j] * rstd;
}

struct TDesc { const float* src; bf16* dst; int ldsrc, lddst; float f8scale; };
__device__ __forceinline__ void t_load(const TDesc& d, int lane, f32x4 (&v)[8]) {
#pragma unroll
    for (int i = 0; i < 8; ++i) v[i] = __builtin_nontemporal_load((const f32x4*)(d.src + (size_t)(8 * i + (lane >> 3)) * d.ldsrc + 4 * (lane & 7)));
}
__device__ __forceinline__ void t_store(const TDesc& d, const f32x4 (&v)[8], LAS float* scr, int lane) {
#pragma unroll
    for (int i = 0; i < 8; ++i) { LAS float* q = scr + (8 * i + (lane >> 3)) * 33 + 4 * (lane & 7); q[0] = v[i][0]; q[1] = v[i][1]; q[2] = v[i][2]; q[3] = v[i][3]; }
    LDS_WAIT(); asm volatile("" ::: "memory");
    const int c = lane & 7;
#pragma unroll
    for (int j = 0; j < 4; ++j) { const int n = (lane >> 3) + 8 * j; const LAS float* sp = scr + (8 * c) * 33 + n;
        if (d.f8scale != 0.f) { const float f = d.f8scale; u32x2 o8; o8.x = pk_fp8x4(sp[0 * 33] * f, sp[1 * 33] * f, sp[2 * 33] * f, sp[3 * 33] * f); o8.y = pk_fp8x4(sp[4 * 33] * f, sp[5 * 33] * f, sp[6 * 33] * f, sp[7 * 33] * f);
            __builtin_nontemporal_store(o8, (u32x2*)((unsigned char*)d.dst + (size_t)n * d.lddst + 8 * c)); }
        else { u32x4 o; o.x = pk2(sp[0 * 33], sp[1 * 33]); o.y = pk2(sp[2 * 33], sp[3 * 33]); o.z = pk2(sp[4 * 33], sp[5 * 33]); o.w = pk2(sp[6 * 33], sp[7 * 33]);
            __builtin_nontemporal_store(o, (u32x4*)(d.dst + (size_t)n * d.lddst + 8 * c)); } }
    LDS_WAIT(); asm volatile("" ::: "memory");
}
constexpr int TI_IN = 32 * 304, TI_PA = 16 * 64, TI_PB = 16 * 64, TI_OUT = 32 * 64, TI_P0 = TI_IN + TI_PA + TI_PB + TI_OUT;
__device__ __forceinline__ TDesc p0_desc(int r, const float* win, const float* wpa, const float* wpb, const float* wout, bf16* WIN, bf16* WP, bf16* WOUT) {
    TDesc d; d.f8scale = 0.f;
    if (r < TI_IN) { const int kb = r / 304, nb = r - kb * 304, nd = 32 * nb; int ns = nd;
        if (nd >= 5632) { const int g = nd - 5632, t = g >> 8, j = g & 255; ns = (j < 128 ? 5648 : 7696 - 128) + 128 * t + j; }
        d.src = win + (size_t)(64 * kb) * IN_W + ns; d.ldsrc = IN_W; d.dst = (bf16*)((unsigned char*)WIN + (size_t)nd * D + 64 * kb); d.lddst = D; d.f8scale = 64.f; return d; }
    r -= TI_IN;
    if (r < TI_PA) { const int kb = r >> 6, nb = r & 63; d.src = wpa + (size_t)(64 * kb) * D + 32 * nb; d.ldsrc = D; d.dst = (bf16*)((unsigned char*)WP + (size_t)(32 * nb) * D + 64 * kb); d.lddst = D; d.f8scale = 64.f; return d; }
    r -= TI_PA;
    if (r < TI_PB) { const int kb = r >> 6, nb = r & 63; d.src = wpb + (size_t)(64 * kb) * D + 32 * nb; d.ldsrc = D; d.dst = (bf16*)((unsigned char*)WP + (size_t)(32 * nb) * D + 1024 + 64 * kb); d.lddst = D; d.f8scale = 64.f; return d; }
    r -= TI_PB;
    { const int kb = r >> 6, nb = r & 63; d.src = wout + (size_t)(64 * kb) * D + 32 * nb; d.ldsrc = D; d.dst = (bf16*)((unsigned char*)WOUT + (size_t)(32 * nb) * D + 64 * kb); d.lddst = D; d.f8scale = 64.f; return d; }
}
constexpr int TI_GU = 32 * 32 * 32, TI_DN = 32 * 8 * 64, TI_MOE = TI_GU + TI_DN;
__device__ __forceinline__ TDesc moe_desc(int r, const float* wgu, const float* wdn, bf16* WGU, bf16* WD) {
    TDesc d; d.f8scale = 0.f;
    if (r < TI_GU) { const int e = r >> 10, rr = r & 1023, kb = rr >> 5, nb = rr & 31, nd = 32 * nb, pn = nd >> 8, j0 = nd & 255;
        const int ns = j0 < 128 ? 128 * pn + j0 : 512 + 128 * pn + (j0 - 128);
        d.src = wgu + (size_t)e * D * 1024 + (size_t)(64 * kb) * 1024 + ns; d.ldsrc = 1024; d.dst = (bf16*)((unsigned char*)WGU + (size_t)e * 1024 * D + (size_t)nd * D + 64 * kb); d.lddst = D; d.f8scale = 64.f; return d; }
    r -= TI_GU;
    { const int e = r >> 9, rr = r & 511, kb = rr >> 6, nb = rr & 63;
        d.src = wdn + (size_t)e * EFF * D + (size_t)(64 * kb) * D + 32 * nb; d.ldsrc = D; d.dst = (bf16*)((unsigned char*)WD + (size_t)e * D * EFF + (size_t)(32 * nb) * EFF + 64 * kb); d.lddst = EFF; d.f8scale = 64.f; return d; }
}

constexpr int MOD_KS = 16;
__device__ __forceinline__ void p0_mod_item(const float* cvec, const float* wada, float* modp, int item, int lane) {
    const int cchunk = item % 192, ks = item / 192, c0 = 64 * cchunk, cg = lane & 15, rg = lane >> 4;
    f32x4 acc[4];
#pragma unroll
    for (int b = 0; b < 4; ++b) acc[b] = (f32x4){0.f, 0.f, 0.f, 0.f};
    const float* wp = wada + (size_t)(128 * ks + rg) * (6 * D) + c0 + 4 * cg;
    const float* cp = cvec + 128 * ks + rg;
#pragma unroll 8
    for (int i = 0; i < 32; ++i) {
        const f32x4 w = __builtin_nontemporal_load((const f32x4*)(wp + (size_t)(4 * i) * (6 * D)));
#pragma unroll
        for (int b = 0; b < 4; ++b) { const float sv = siluf_(cp[b * D + 4 * i]); acc[b] = acc[b] + w * sv; }
    }
#pragma unroll
    for (int b = 0; b < 4; ++b)
#pragma unroll
        for (int j = 0; j < 4; ++j) { float v = acc[b][j]; v += shx(v, 16, lane); v += shx(v, 32, lane); acc[b][j] = v; }
    if (rg == 0) {
#pragma unroll
        for (int b = 0; b < 4; ++b) *(f32x4*)(modp + ((size_t)ks * 4 + b) * (6 * D) + c0 + 4 * cg) = acc[b];
    }
}
__device__ __forceinline__ float mod_sum(const float* modp, size_t o) { float v = 0.f;
#pragma unroll
    for (int ks = 0; ks < MOD_KS; ++ks) v += modp[o + (size_t)ks * 4 * 6 * D];
    return v; }

__device__ __forceinline__ f32x16 zero16() { f32x16 z;
#pragma unroll
    for (int i = 0; i < 16; ++i) z[i] = 0.f;
    return z; }

constexpr int ATT_KS_STRIDE = 144;
constexpr int ATT_VT_STRIDE = 196;
constexpr int ATT_VT_OFF = 192 * ATT_KS_STRIDE;
__device__ __forceinline__ void swa_unit(LAS unsigned char* lds, const bf16* HC, bf16* OAOB, const float* sinks, int unit, int tid, int lane, int wave) {
    const int kvh = unit & 3, n = (unit >> 2) & 63, b = unit >> 8;
    const int nkc = n < 2 ? n + 1 : 3;
    const int key0 = (n + 1 - nkc) * 64;
    const size_t tokb = (size_t)b * SEQ;
    LAS unsigned char* Ks = lds;
    LAS unsigned short* Vt = (LAS unsigned short*)(lds + ATT_VT_OFF);
    __syncthreads();
    const int nkeys = nkc * 64;
    for (int p = tid; p < nkeys * 8; p += NTHREADS) {
        const int key = p >> 3, dc = p & 7;
        const bf16* src = HC + (tokb + key0 + key) * HC_W;
        const u32x4 kv = *(const u32x4*)(src + 1024 + kvh * 64 + dc * 8);
        const u32x4 vv = *(const u32x4*)(src + 1280 + kvh * 64 + dc * 8);
        *(LAS u32x4*)(Ks + key * ATT_KS_STRIDE + dc * 16) = kv;
        LAS unsigned short* vt = Vt + (dc * 8) * ATT_VT_STRIDE + key;
        vt[0 * ATT_VT_STRIDE] = (unsigned short)(vv.x & 0xffffu); vt[1 * ATT_VT_STRIDE] = (unsigned short)(vv.x >> 16);
        vt[2 * ATT_VT_STRIDE] = (unsigned short)(vv.y & 0xffffu); vt[3 * ATT_VT_STRIDE] = (unsigned short)(vv.y >> 16);
        vt[4 * ATT_VT_STRIDE] = (unsigned short)(vv.z & 0xffffu); vt[5 * ATT_VT_STRIDE] = (unsigned short)(vv.z >> 16);
        vt[6 * ATT_VT_STRIDE] = (unsigned short)(vv.w & 0xffffu); vt[7 * ATT_VT_STRIDE] = (unsigned short)(vv.w >> 16);
    }
    __syncthreads();
    const int g = wave >> 1, th = wave & 1, r31 = lane & 31, h = lane >> 5;
    const int head = kvh * 4 + g;
    const size_t qtok = tokb + (size_t)n * 64 + th * 32 + r31;
    bf16x8 qf[4];
#pragma unroll
    for (int ks = 0; ks < 4; ++ks) qf[ks] = *(const bf16x8*)(HC + qtok * HC_W + head * 64 + ks * 16 + 8 * h);
    const int nkt = 2 * nkc;
    f32x16 s[6];
#pragma unroll
    for (int kt = 0; kt < 6; ++kt) {
        s[kt] = zero16();
        if (kt < nkt) {
#pragma unroll
            for (int ks = 0; ks < 4; ++ks) {
                const bf16x8 A = *(const LAS bf16x8*)(Ks + (kt * 32 + r31) * ATT_KS_STRIDE + (ks * 16 + 8 * h) * 2);
                s[kt] = __builtin_amdgcn_mfma_f32_32x32x16_bf16(A, qf[ks], s[kt], 0, 0, 0);
            }
        }
    }
    const float sink = sinks[head];
    float mx = sink;
#pragma unroll
    for (int kt = 0; kt < 6; ++kt) if (kt < nkt) {
#pragma unroll
        for (int i = 0; i < 16; ++i) mx = fmaxf(mx, s[kt][i]); }
    mx = fmaxf(mx, shx(mx, 32, lane));
    float sum = 0.f;
#pragma unroll
    for (int kt = 0; kt < 6; ++kt) if (kt < nkt) {
#pragma unroll
        for (int i = 0; i < 16; ++i) { const float pv = __expf(s[kt][i] - mx); s[kt][i] = pv; sum += pv; } }
    sum += shx(sum, 32, lane);
    sum += __expf(sink - mx);
    const float inv = 1.f / sum;
    f32x16 o[2]; o[0] = zero16(); o[1] = zero16();
#pragma unroll
    for (int kt = 0; kt < 6; ++kt) if (kt < nkt) {
#pragma unroll
        for (int st = 0; st < 2; ++st) {
            u32x4 pb; pb.x = pk2(s[kt][8 * st + 0], s[kt][8 * st + 1]); pb.y = pk2(s[kt][8 * st + 2], s[kt][8 * st + 3]); pb.z = pk2(s[kt][8 * st + 4], s[kt][8 * st + 5]); pb.w = pk2(s[kt][8 * st + 6], s[kt][8 * st + 7]);
            const bf16x8 B = __builtin_bit_cast(bf16x8, pb);
#pragma unroll
            for (int mt = 0; mt < 2; ++mt) {
                const LAS unsigned short* vp = Vt + (32 * mt + r31) * ATT_VT_STRIDE + kt * 32 + 16 * st + 4 * h;
                const u32x2 a0 = *(const LAS u32x2*)vp, a1 = *(const LAS u32x2*)(vp + 8);
                u32x4 av; av.x = a0.x; av.y = a0.y; av.z = a1.x; av.w = a1.y;
                o[mt] = __builtin_amdgcn_mfma_f32_32x32x16_bf16(__builtin_bit_cast(bf16x8, av), B, o[mt], 0, 0, 0);
            }
        }
    }
    unsigned char* orow = (unsigned char*)OAOB + qtok * D + head * 64;
    const float inv4 = 4.f * inv;
#pragma unroll
    for (int mt = 0; mt < 2; ++mt)
#pragma unroll
        for (int rg = 0; rg < 4; ++rg)
            *(unsigned*)(orow + 32 * mt + 8 * rg + 4 * h) = pk_fp8x4(o[mt][4 * rg + 0] * inv4, o[mt][4 * rg + 1] * inv4, o[mt][4 * rg + 2] * inv4, o[mt][4 * rg + 3] * inv4);
}

constexpr int GU_NW = 0, GU_UT = 16384, GU_QD = 32768, GU_KDT = 49152, GU_QK = 65536, GU_BYTES = 73728;
constexpr int GP_Y = 67584, GP_SM = 67584 + 73728;
#define GP_ROW(t) ((t) * 272 + 16 * ((t) >> 3))
constexpr int GP_QN = 17520, GP_KE = 35040, GP_VB = 52560;
__host__ __device__ __forceinline__ constexpr int tri_off(int i) { const int a = i >> 2, r = i & 3; return 8 * a * a + 4 * a + (r >= 1 ? 4 * a : 0) + (r >= 2 ? 4 * a + 4 : 0) + (r == 3 ? 4 * a + 4 : 0); }

__host__ __device__ __forceinline__ constexpr int kperm4(int k) { return (k & ~31) + 8 * ((k >> 2) & 3) + 4 * ((k >> 4) & 1) + (k & 3); }
__device__ __forceinline__ void conv8(const u32x4 (&rows)[5], const LAS float* cw, float (&y)[2][8]) {
    float xr[5][8];
#pragma unroll
    for (int r = 0; r < 5; ++r) { const u32x4 w = rows[r];
        xr[r][0] = bflo(w.x); xr[r][1] = bfhi(w.x); xr[r][2] = bflo(w.y); xr[r][3] = bfhi(w.y); xr[r][4] = bflo(w.z); xr[r][5] = bfhi(w.z); xr[r][6] = bflo(w.w); xr[r][7] = bfhi(w.w); }
    float wv[4][8];
#pragma unroll
    for (int i = 0; i < 4; ++i) { const f32x4 a = *(const LAS f32x4*)(cw + i * 128), b = *(const LAS f32x4*)(cw + i * 128 + 4);
        wv[i][0] = a[0]; wv[i][1] = a[1]; wv[i][2] = a[2]; wv[i][3] = a[3]; wv[i][4] = b[0]; wv[i][5] = b[1]; wv[i][6] = b[2]; wv[i][7] = b[3]; }
#pragma unroll
    for (int d = 0; d < 8; ++d) {
        const float y0 = ((xr[0][d] * wv[0][d] + xr[1][d] * wv[1][d]) + xr[2][d] * wv[2][d]) + xr[3][d] * wv[3][d];
        const float y1 = ((xr[1][d] * wv[0][d] + xr[2][d] * wv[1][d]) + xr[3][d] * wv[2][d]) + xr[4][d] * wv[3][d];
        y[0][d] = siluf_(y0); y[1][d] = siluf_(y1);
    }
}
__device__ __forceinline__ float red16(float v, int lane) { v += shx(v, 1, lane); v += shx(v, 2, lane); v += shx(v, 4, lane); v += shx(v, 8, lane); return v; }
__device__ __forceinline__ u32x4 pack8(const float (&v)[8]) { u32x4 w; w.x = pk2(v[0], v[1]); w.y = pk2(v[2], v[3]); w.z = pk2(v[4], v[5]); w.w = pk2(v[6], v[7]); return w; }
__device__ __forceinline__ u32x2 pack4(const f32x4 v) { u32x2 w; w.x = pk2(v[0], v[1]); w.y = pk2(v[2], v[3]); return w; }

__device__ __forceinline__ void gdn_pre(LAS unsigned char* lds, const bf16* HC, const float* convw, const float* BETA, const float* GG, unsigned char* GDN, unsigned char* SCR, float* DECS, int ug, int tid, int lane, int wave) {
    asm volatile("" : "+v"(tid), "+v"(lane));
    LAS float* AM = (LAS float*)lds;
    LAS unsigned char* YR = lds + GP_Y;
    LAS float* SM = (LAS float*)(lds + GP_SM);
    const int fr = lane & 15, fq = lane >> 4;
    LAS float* CW = (LAS float*)(lds + GP_SM + 1024);
    {
        const int h0 = ((ug * 8) >> 6) & 7;
        for (int i = tid; i < 1536; i += NTHREADS) { const int ts = i >> 9, tap = (i >> 7) & 3, d = i & 127; CW[i] = convw[(size_t)tap * 3072 + ts * 1024 + h0 * 128 + d]; }
    }
    u32x4 nr[3][5]; float nbt = 0.f, ngv = 0.f;
#define GP_LOADROWS(u_) do { const int _c = (u_) & 63, _h = ((u_) >> 6) & 7, _b = (u_) >> 9; int _dg = tid & 15, _tq = tid >> 4; asm volatile("" : "+v"(_dg), "+v"(_tq));     \
        const int _t0 = 2 * _tq; const bf16* _base = HC + ((size_t)_b * SEQ + (size_t)_c * 64) * HC_W + _h * 128 + 1536 + 8 * _dg; const bool _z = (_c == 0); \
        _Pragma("unroll") for (int ts = 0; ts < 3; ++ts) _Pragma("unroll") for (int r = 0; r < 5; ++r) { const bool _zz = _z && (_t0 - 3 + r < 0); \
            const u32x4 _w = *(const u32x4*)(_base + (ptrdiff_t)(_zz ? 0 : (_t0 - 3 + r)) * HC_W + ts * 1024); \
            nr[ts][r] = _zz ? (u32x4){0u, 0u, 0u, 0u} : _w; } \
        if (wave == 0) { const size_t _tk = (size_t)_b * SEQ + (size_t)_c * 64 + lane; ngv = GG[_tk * 8 + _h]; nbt = BETA[_tk * 8 + _h]; } } while (0)
    GP_LOADROWS(ug * 8);
    const int lane_outer = lane;
#pragma unroll 1
    for (int uu = 0; uu < 8; ++uu) {
        int lane_it = lane_outer; asm volatile("" : "+v"(lane_it));
        const int lane = lane_it, tid = wave * 64 + lane_it;
        const int u = ug * 8 + uu;
        unsigned char* gb = GDN + (size_t)u * GU_BYTES;
        unsigned char* sb = SCR + (size_t)u * 32768;
        const float gv = ngv, btw = nbt;
        __syncthreads();
        if (wave == 0) {
            float xs = gv;
#pragma unroll
            for (int off = 1; off < 64; off <<= 1) { const float yv = shl_(xs, lane >= off ? lane - off : lane); if (lane >= off) xs += yv; }
            const float last = shl_(xs, 63);
            SM[lane] = xs; SM[64 + lane] = btw; SM[128 + lane] = __expf(xs); SM[192 + lane] = __expf(last - xs);
            if (lane == 0) DECS[u] = __expf(last);
        }
        __syncthreads();
        {
            int dg = tid & 15, tq = tid >> 4; asm volatile("" : "+v"(dg), "+v"(tq));
            const int t0 = 2 * tq;
            float qv[2][8], kv[2][8], vv[2][8];
            conv8(nr[0], CW + 8 * dg, qv);
            conv8(nr[1], CW + 512 + 8 * dg, kv);
            conv8(nr[2], CW + 1024 + 8 * dg, vv);
            asm volatile("" ::: "memory");
            { const int un = uu + 1 < 8 ? u + 1 : u; GP_LOADROWS(un); }
            float bt[2], ec[2], ek[2];
#pragma unroll
            for (int r = 0; r < 2; ++r) { bt[r] = SM[64 + t0 + r]; ec[r] = SM[128 + t0 + r]; ek[r] = SM[192 + t0 + r]; }
#pragma unroll
            for (int r = 0; r < 2; ++r) {
                float sq = 0.f, sk = 0.f;
#pragma unroll
                for (int d = 0; d < 8; ++d) { sq += qv[r][d] * qv[r][d]; sk += kv[r][d] * kv[r][d]; }
                sq = red16(sq, lane); sk = red16(sk, lane);
                const float rq = rsqrtf(sq + 1e-6f) * 0.08838834764831845f, rk = rsqrtf(sk + 1e-6f);
                float qd[8];
#pragma unroll
                for (int d = 0; d < 8; ++d) { qv[r][d] *= rq; kv[r][d] *= rk; qd[d] = qv[r][d] * ec[r]; }
                const int ro = GP_ROW(t0 + r) + 16 * dg;
                *(LAS u32x4*)(YR + ro) = pack8(kv[r]);
                *(LAS u32x4*)(YR + GP_QN + ro) = pack8(qv[r]);
                { float ke[8], vb[8];
#pragma unroll
                  for (int d = 0; d < 8; ++d) { ke[d] = kv[r][d] * ek[r]; vb[d] = vv[r][d] * bt[r]; }
                  *(LAS u32x4*)(YR + GP_KE + ro) = pack8(ke); *(LAS u32x4*)(YR + GP_VB + ro) = pack8(vb); }
                { const u32x4 w8 = pack8(qd); *(u32x2*)(gb + GU_QD + ((t0 + r) * 128 + kperm4(8 * dg)) * 2) = (u32x2){w8.x, w8.y}; *(u32x2*)(gb + GU_QD + ((t0 + r) * 128 + kperm4(8 * dg + 4)) * 2) = (u32x2){w8.z, w8.w}; }
            }
        }
        __syncthreads();
        {
#pragma unroll
            for (int q = 0; q < 2; ++q) {
                int pp = tid + q * NTHREADS; asm volatile("" : "+v"(pp));
                const int d = pp >> 3, j = pp & 7;
                const LAS unsigned char* colp = YR + 2 * d;
                unsigned hv[8];
#pragma unroll
                for (int k = 0; k < 8; ++k) hv[k] = *(const LAS unsigned short*)(colp + GP_VB + GP_ROW(8 * j + k));
                { u32x4 w; w.x = hv[0] | (hv[1] << 16); w.y = hv[2] | (hv[3] << 16); w.z = hv[4] | (hv[5] << 16); w.w = hv[6] | (hv[7] << 16); *(u32x4*)(sb + (d * 64 + 8 * j) * 2) = w; }
                { float kb[8];
#pragma unroll
                  for (int k = 0; k < 8; ++k) { const int t = 8 * j + k; kb[k] = __uint_as_float((unsigned)(*(const LAS unsigned short*)(colp + GP_ROW(t))) << 16) * (SM[64 + t] * SM[128 + t]); }
                  *(u32x4*)(sb + 16384 + (d * 64 + 8 * j) * 2) = pack8(kb); }
                { const int tb = 32 * (j >> 2) + 4 * (j & 3);
#pragma unroll
                  for (int k = 0; k < 8; ++k) hv[k] = *(const LAS unsigned short*)(colp + GP_KE + GP_ROW(tb + (k & 3) + 16 * (k >> 2)));
                  u32x4 w; w.x = hv[0] | (hv[1] << 16); w.y = hv[2] | (hv[3] << 16); w.z = hv[4] | (hv[5] << 16); w.w = hv[6] | (hv[7] << 16); *(u32x4*)(gb + GU_KDT + (d * 64 + 8 * j) * 2) = w; }
            }
        }
        {
            const int mt = wave & 3;
            int fr = lane & 15, fq = lane >> 4; asm volatile("" : "+v"(fr), "+v"(fq));
            if (wave < 4) {
#pragma unroll
                for (int nt = 0; nt < 4; ++nt) if (nt <= mt) {
                    f32x4 cacc = (f32x4){0.f, 0.f, 0.f, 0.f};
#pragma unroll
                    for (int sx = 0; sx < 4; ++sx) {
                        const bf16x8 A = *(const LAS bf16x8*)(YR + GP_ROW(16 * mt + fr) + (32 * sx + 8 * fq) * 2), B = *(const LAS bf16x8*)(YR + GP_ROW(16 * nt + fr) + (32 * sx + 8 * fq) * 2);
                        cacc = __builtin_amdgcn_mfma_f32_16x16x32_bf16(A, B, cacc, 0, 0, 0);
                    }
                    const int jj = 16 * nt + fr; const float cj = SM[jj];
#pragma unroll
                    for (int r = 0; r < 4; ++r) { const int i = 16 * mt + 4 * fq + r;
                        const float val = (i > jj) ? SM[64 + i] * cacc[r] * __expf(SM[i] - cj) : 0.f;
                        if (jj < ((i + 3) & ~3)) AM[uu * 2112 + tri_off(i) + jj] = val; }
                }
            } else {
#pragma unroll
                for (int jp = 0; jp < 2; ++jp) {
                    u32x2 half[2];
#pragma unroll
                    for (int jh = 0; jh < 2; ++jh) { const int jt = 2 * jp + jh;
                        f32x4 cacc = (f32x4){0.f, 0.f, 0.f, 0.f};
                        if (jt <= mt) {
#pragma unroll
                            for (int sx = 0; sx < 4; ++sx) {
                                const bf16x8 A = *(const LAS bf16x8*)(YR + GP_ROW(16 * jt + fr) + (32 * sx + 8 * fq) * 2), B = *(const LAS bf16x8*)(YR + GP_QN + GP_ROW(16 * mt + fr) + (32 * sx + 8 * fq) * 2);
                                cacc = __builtin_amdgcn_mfma_f32_16x16x32_bf16(A, B, cacc, 0, 0, 0);
                            }
                        }
                        const int i = 16 * mt + fr; const float ci = SM[i];
                        f32x4 o;
#pragma unroll
                        for (int r = 0; r < 4; ++r) { const int jj = 16 * jt + 4 * fq + r; o[r] = (i >= jj) ? cacc[r] * __expf(ci - SM[jj]) : 0.f; }
                        half[jh] = pack4(o); }
                    *(u32x4*)(gb + GU_QK + ((16 * mt + fr) * 64 + 32 * jp + 8 * fq) * 2) = (u32x4){half[0].x, half[0].y, half[1].x, half[1].y};
                }
            }
        }
    }
#undef GP_LOADROWS
    __syncthreads();
    {
        const LAS float* A = AM + wave * 2112;
        int lo = lane; asm volatile("" : "+v"(lo));
        float T[64];
#pragma unroll
        for (int i = 0; i < 64; ++i) {
            float acc = (lo == i) ? 1.f : 0.f;
#pragma unroll
            for (int j4 = 0; j4 < i; j4 += 4) {
                const f32x4 av = *(const LAS f32x4*)(A + tri_off(i) + j4);
                acc -= av[0] * T[j4];
                if (j4 + 1 < i) acc -= av[1] * T[j4 + 1];
                if (j4 + 2 < i) acc -= av[2] * T[j4 + 2];
                if (j4 + 3 < i) acc -= av[3] * T[j4 + 3];
            }
            T[i] = acc;
        }
        LAS unsigned short* Tb = (LAS unsigned short*)YR + wave * (64 * 72);
#pragma unroll
        for (int i = 0; i < 64; ++i) { const __bf16 hb = (__bf16)T[i]; Tb[i * 72 + lo] = __builtin_bit_cast(unsigned short, hb); }
    }
    asm volatile("" : "+v"(tid), "+v"(lane));
    const int frc = lane & 15, fqc = lane >> 4;
    u32x4 pv[4];
#define GP_LOADVK(u_) do { const unsigned char* _sb = SCR + (size_t)(u_) * 32768; int _t = tid; asm volatile("" : "+v"(_t)); \
        _Pragma("unroll") for (int q = 0; q < 4; ++q) { const int p = _t + q * NTHREADS, ts = p >> 10, pp = p & 1023, d = pp >> 3, ch = pp & 7; pv[q] = *(const u32x4*)(_sb + ts * 16384 + (d * 64 + ch * 8) * 2); } } while (0)
    GP_LOADVK(ug * 8);
#pragma unroll 1
    for (int uu = 0; uu < 8; ++uu) {
        const int u = ug * 8 + uu;
        unsigned char* gb = GDN + (size_t)u * GU_BYTES;
        __syncthreads();
#pragma unroll
        for (int q = 0; q < 4; ++q) { const int p = tid + q * NTHREADS, ts = p >> 10, pp = p & 1023, d = pp >> 3, ch = pp & 7; *(LAS u32x4*)(lds + ts * 18432 + d * 144 + ch * 16) = pv[q]; }
        { const int un = uu + 1 < 8 ? u + 1 : u; GP_LOADVK(un); }
        __syncthreads();
        const LAS unsigned char* Tu = YR + uu * 9216;
#pragma unroll
        for (int mt = 0; mt < 4; ++mt) {
            f32x4 cu = (f32x4){0.f, 0.f, 0.f, 0.f}, cw = (f32x4){0.f, 0.f, 0.f, 0.f};
#pragma unroll
            for (int sx = 0; sx < 2; ++sx) {
                const bf16x8 Tf = *(const LAS bf16x8*)(Tu + ((16 * mt + frc) * 72 + 32 * sx + 8 * fqc) * 2);
                const bf16x8 Vf = *(const LAS bf16x8*)(lds + ((16 * wave + frc) * 72 + 32 * sx + 8 * fqc) * 2);
                const bf16x8 Kf = *(const LAS bf16x8*)(lds + 18432 + ((16 * wave + frc) * 72 + 32 * sx + 8 * fqc) * 2);
                cu = __builtin_amdgcn_mfma_f32_16x16x32_bf16(Tf, Vf, cu, 0, 0, 0);
                cw = __builtin_amdgcn_mfma_f32_16x16x32_bf16(Kf, Tf, cw, 0, 0, 0);
            }
            *(u32x2*)(gb + GU_UT + ((16 * wave + frc) * 64 + 16 * mt + 4 * fqc) * 2) = pack4(cu);
            *(u32x2*)(gb + GU_NW + ((16 * mt + frc) * 128 + kperm4(16 * wave + 4 * fqc)) * 2) = pack4(-cw);
        }
    }
#undef GP_LOADVK
}

__device__ __forceinline__ bf16x8 lda2(const LAS unsigned char* p) { const u32x2 a0 = *(const LAS u32x2*)p, a1 = *(const LAS u32x2*)(p + 32); u32x4 av; av.x = a0.x; av.y = a0.y; av.z = a1.x; av.w = a1.y; return __builtin_bit_cast(bf16x8, av); }
__device__ __forceinline__ bf16x8 packB(const f32x4 t0, const f32x4 t1) { u32x4 w; w.x = pk2(t0[0], t0[1]); w.y = pk2(t0[2], t0[3]); w.z = pk2(t1[0], t1[1]); w.w = pk2(t1[2], t1[3]); return __builtin_bit_cast(bf16x8, w); }

constexpr int SB_NW = 0, SB_QD = 17408, SB_KDT = 34816, SB_QK = 53248, SB_BYTES = 62464;
__device__ __forceinline__ float dpp_xor1(float v) { return __int_as_float(__builtin_amdgcn_update_dpp(0, __float_as_int(v), 0xB1, 0xF, 0xF, false)); }
__device__ __forceinline__ float dpp_xor2(float v) { return __int_as_float(__builtin_amdgcn_update_dpp(0, __float_as_int(v), 0x4E, 0xF, 0xF, false)); }
__device__ __forceinline__ float dpp_xor4(float v) { int t = __builtin_amdgcn_update_dpp(0, __float_as_int(v), 0x104, 0xF, 0x5, false);
    t = __builtin_amdgcn_update_dpp(t, __float_as_int(v), 0x114, 0xF, 0xA, false); return __int_as_float(t); }
__device__ __forceinline__ float dpp_xor8(float v) { return __int_as_float(__builtin_amdgcn_update_dpp(0, __float_as_int(v), 0x128, 0xF, 0xF, false)); }
__device__ __forceinline__ float tred16(const float (&v)[16], int fr) {
    float a[8], b[4], c[2];
#pragma unroll
    for (int i = 0; i < 8; ++i) { const bool up = (fr & 8) != 0; const float keep = up ? v[i + 8] : v[i], send = up ? v[i] : v[i + 8]; a[i] = keep + dpp_xor8(send); }
#pragma unroll
    for (int i = 0; i < 4; ++i) { const bool up = (fr & 4) != 0; const float keep = up ? a[i + 4] : a[i], send = up ? a[i] : a[i + 4]; b[i] = keep + dpp_xor4(send); }
#pragma unroll
    for (int i = 0; i < 2; ++i) { const bool up = (fr & 2) != 0; const float keep = up ? b[i + 2] : b[i], send = up ? b[i] : b[i + 2]; c[i] = keep + dpp_xor2(send); }
    const bool up = (fr & 1) != 0; const float keep = up ? c[1] : c[0], send = up ? c[0] : c[1];
    return keep + dpp_xor1(send);
}
__device__ __forceinline__ void gdn_scan(LAS unsigned char* lds, const unsigned char* GDN, const float* DECS, const bf16* HC, const float* normw, bf16* OAOB, float* SSQ, int bh, int half, int tid, int lane, int wave) {
    constexpr int SQ_OFF = 2 * SB_BYTES, OT_OFF = SQ_OFF + 2048, OT_STRIDE = 144, OT_BYTES = 64 * OT_STRIDE;
    LAS float* SQ = (LAS float*)(lds + SQ_OFF);
    LAS unsigned char* OT = lds + OT_OFF;
    LAS float* NWL = (LAS float*)(lds + OT_OFF + 2 * OT_BYTES);
    LAS float* DL = NWL + 64;
    const int fr = lane & 15, fq = lane >> 4, b = bh >> 3, h = bh & 7;
    if (tid < 64) { NWL[tid] = normw[64 * half + tid]; DL[tid] = DECS[bh * 64 + tid]; }
    const unsigned char* gbase = GDN + (size_t)bh * 64 * GU_BYTES;
    if (wave < 4) {
        const int cw = wave, dvl = 16 * cw + fr, dv = 64 * half + dvl;
        const int myrow = 16 * (fr >> 2) + 4 * fq + (fr & 3);
        const int uo = GU_UT + (dv * 64 + 4 * fq) * 2;
        u32x2 UA[4], UB[4];
#define SC_LOADU(cc, U) do { const unsigned char* _g = gbase + (size_t)(cc) * GU_BYTES + uo; _Pragma("unroll") for (int mt = 0; mt < 4; ++mt) U[mt] = *(const u32x2*)(_g + 32 * mt); } while (0)
        SC_LOADU(0, UA); SC_LOADU(1, UB);
        f32x4 S[8];
#pragma unroll
        for (int kt = 0; kt < 8; ++kt) S[kt] = (f32x4){0.f, 0.f, 0.f, 0.f};
        __syncthreads();
        auto cstep = [&](const int c, u32x2 (&U)[4]) __attribute__((always_inline)) {
            const int cur = c & 1;
            const LAS unsigned char* L = lds + cur * SB_BYTES;
            f32x4 vn[4], o[4];
#pragma unroll
            for (int mt = 0; mt < 4; ++mt) vn[mt] = (f32x4){bflo(U[mt].x), bfhi(U[mt].x), bflo(U[mt].y), bfhi(U[mt].y)};
            { const int c2 = c + 2 < 64 ? c + 2 : 63; SC_LOADU(c2, U); }
            const float cdec = DL[c];
            bf16x8 bS[4];
#pragma unroll
            for (int sx = 0; sx < 4; ++sx) bS[sx] = packB(S[2 * sx], S[2 * sx + 1]);
#define SC_FRAG(base, row, stride, sx) (*(const LAS bf16x8*)(L + (base) + (row) * (stride) + (32 * (sx) + 8 * fq) * 2))
#define SC_SB __builtin_amdgcn_sched_barrier(0)
            bf16x8 f0[8], f1[8];
            SC_SB;
#pragma unroll
            for (int q = 0; q < 8; ++q) f0[q] = SC_FRAG(SB_NW, 16 * (q >> 2) + fr, 272, q & 3);
            SC_SB;
#pragma unroll
            for (int q = 0; q < 8; ++q) f1[q] = SC_FRAG(SB_NW, 16 * (2 + (q >> 2)) + fr, 272, q & 3);
#pragma unroll
            for (int q = 0; q < 8; ++q) vn[q >> 2] = __builtin_amdgcn_mfma_f32_16x16x32_bf16(f0[q], bS[q & 3], vn[q >> 2], 0, 0, 0);
            SC_SB;
#pragma unroll
            for (int q = 0; q < 8; ++q) f0[q] = SC_FRAG(SB_QD, 16 * (q >> 2) + fr, 272, q & 3);
#pragma unroll
            for (int q = 0; q < 8; ++q) vn[2 + (q >> 2)] = __builtin_amdgcn_mfma_f32_16x16x32_bf16(f1[q], bS[q & 3], vn[2 + (q >> 2)], 0, 0, 0);
            SC_SB;
#pragma unroll
            for (int mt = 0; mt < 4; ++mt) o[mt] = (f32x4){0.f, 0.f, 0.f, 0.f};
#pragma unroll
            for (int q = 0; q < 8; ++q) f1[q] = SC_FRAG(SB_QD, 16 * (2 + (q >> 2)) + fr, 272, q & 3);
#pragma unroll
            for (int q = 0; q < 8; ++q) o[q >> 2] = __builtin_amdgcn_mfma_f32_16x16x32_bf16(f0[q], bS[q & 3], o[q >> 2], 0, 0, 0);
            SC_SB;
            bf16x8 bV[2];
            bV[0] = packB(vn[0], vn[1]); bV[1] = packB(vn[2], vn[3]);
#pragma unroll
            for (int q = 0; q < 8; ++q) f0[q] = SC_FRAG(SB_QK, 16 * (q >> 1) + fr, 144, q & 1);
#pragma unroll
            for (int q = 0; q < 8; ++q) o[2 + (q >> 2)] = __builtin_amdgcn_mfma_f32_16x16x32_bf16(f1[q], bS[q & 3], o[2 + (q >> 2)], 0, 0, 0);
            SC_SB;
#pragma unroll
            for (int q = 0; q < 8; ++q) f1[q] = SC_FRAG(SB_KDT, 16 * (q >> 1) + fr, 144, q & 1);
#pragma unroll
            for (int q = 0; q < 8; ++q) o[q >> 1] = __builtin_amdgcn_mfma_f32_16x16x32_bf16(f0[q], bV[q & 1], o[q >> 1], 0, 0, 0);
            SC_SB;
#pragma unroll
            for (int kt = 0; kt < 8; ++kt) S[kt] = S[kt] * cdec;
#pragma unroll
            for (int q = 0; q < 8; ++q) f0[q] = SC_FRAG(SB_KDT, 16 * (4 + (q >> 1)) + fr, 144, q & 1);
#pragma unroll
            for (int q = 0; q < 8; ++q) S[q >> 1] = __builtin_amdgcn_mfma_f32_16x16x32_bf16(f1[q], bV[q & 1], S[q >> 1], 0, 0, 0);
            SC_SB;
#pragma unroll
            for (int q = 0; q < 8; ++q) S[4 + (q >> 1)] = __builtin_amdgcn_mfma_f32_16x16x32_bf16(f0[q], bV[q & 1], S[4 + (q >> 1)], 0, 0, 0);
            SC_SB;
#undef SC_FRAG
#undef SC_SB
            float ssv[16];
            LAS unsigned short* ot = (LAS unsigned short*)(OT + cur * OT_BYTES + (4 * fq) * OT_STRIDE + dvl * 2);
#pragma unroll
            for (int mt = 0; mt < 4; ++mt)
#pragma unroll
                for (int r = 0; r < 4; ++r) { ssv[mt * 4 + r] = o[mt][r] * o[mt][r]; const __bf16 hb = (__bf16)o[mt][r]; ot[((16 * mt + r) * OT_STRIDE) / 2] = __builtin_bit_cast(unsigned short, hb); }
            SQ[cur * 256 + myrow * 4 + cw] = tred16(ssv, fr);
            asm volatile("s_waitcnt lgkmcnt(0)" ::: "memory"); __builtin_amdgcn_s_barrier(); asm volatile("" ::: "memory");
        };
#pragma unroll 1
        for (int c = 0; c < 64; c += 2) { cstep(c, UA); cstep(c + 1, UB); }
#undef SC_LOADU
    } else {
        const int t = tid - 256;
        const int r16 = t >> 4, c16 = t & 15, r8 = t >> 3, c8 = t & 7;
        const int go = t * 16;
        const int dA = r16 * 272 + c16 * 16, dB = r8 * 144 + c8 * 16;
        u32x4 X[14], Y[14], ZA[2], ZB[2];
#define SC_LOADX(cc, P) do { const unsigned char* _g = gbase + (size_t)(cc) * GU_BYTES + go; \
        _Pragma("unroll") for (int j = 0; j < 4; ++j) { P[j] = *(const u32x4*)(_g + GU_NW + 4096 * j); P[4 + j] = *(const u32x4*)(_g + GU_QD + 4096 * j); P[8 + j] = *(const u32x4*)(_g + GU_KDT + 4096 * j); } \
        P[12] = *(const u32x4*)(_g + GU_QK); P[13] = *(const u32x4*)(_g + GU_QK + 4096); } while (0)
#define SC_STOREX(bufsel, P) do { LAS unsigned char* _l = lds + (bufsel) * SB_BYTES; \
        _Pragma("unroll") for (int j = 0; j < 4; ++j) { *(LAS u32x4*)(_l + SB_NW + dA + 16 * 272 * j) = P[j]; *(LAS u32x4*)(_l + SB_QD + dA + 16 * 272 * j) = P[4 + j]; *(LAS u32x4*)(_l + SB_KDT + dB + 32 * 144 * j) = P[8 + j]; } \
        *(LAS u32x4*)(_l + SB_QK + dB) = P[12]; *(LAS u32x4*)(_l + SB_QK + dB + 32 * 144) = P[13]; } while (0)
#define SC_LOADZ(cc, Z) do { const bf16* _z = HC + ((size_t)b * SEQ + (size_t)(cc) * 64 + r8) * HC_W + 4608 + h * 128 + 64 * half + 8 * c8; Z[0] = *(const u32x4*)_z; Z[1] = *(const u32x4*)(_z + (size_t)32 * HC_W); } while (0)
        auto ostage = [&](const int cc, const u32x4 (&Z)[2]) __attribute__((always_inline)) {
            const int ob = cc & 1;
            const size_t tok0 = (size_t)b * SEQ + (size_t)cc * 64;
            const f32x4 nwa = *(const LAS f32x4*)(NWL + 8 * c8), nwb = *(const LAS f32x4*)(NWL + 8 * c8 + 4);
#pragma unroll
            for (int j = 0; j < 2; ++j) {
                const int row = r8 + 32 * j;
                const u32x4 ov = *(const LAS u32x4*)(OT + ob * OT_BYTES + row * OT_STRIDE + c8 * 16);
                const u32x4 zq = Z[j];
                float w8[8];
                w8[0] = bflo(ov.x) * bflo(zq.x) * nwa[0]; w8[1] = bfhi(ov.x) * bfhi(zq.x) * nwa[1]; w8[2] = bflo(ov.y) * bflo(zq.y) * nwa[2]; w8[3] = bfhi(ov.y) * bfhi(zq.y) * nwa[3];
                w8[4] = bflo(ov.z) * bflo(zq.z) * nwb[0]; w8[5] = bfhi(ov.z) * bfhi(zq.z) * nwb[1]; w8[6] = bflo(ov.w) * bflo(zq.w) * nwb[2]; w8[7] = bfhi(ov.w) * bfhi(zq.w) * nwb[3];
                *(u32x4*)(OAOB + (tok0 + row) * D + 1024 + h * 128 + 64 * half + 8 * c8) = pack8(w8);
                if (c8 == 0) { const f32x4 p0 = *(const LAS f32x4*)(SQ + ob * 256 + row * 4); SSQ[((size_t)half * MTOK + tok0 + row) * 8 + h] = (p0[0] + p0[1]) + (p0[2] + p0[3]); }
            }
        };
        SC_LOADX(0, X); SC_STOREX(0, X);
        SC_LOADX(1, X); SC_LOADX(2, Y);
        SC_LOADZ(0, ZA); SC_LOADZ(1, ZB);
        __syncthreads();
        SC_STOREX(1, X); SC_LOADX(3, X);
        asm volatile("s_waitcnt lgkmcnt(0)" ::: "memory"); __builtin_amdgcn_s_barrier(); asm volatile("" ::: "memory");
        auto sstep = [&](const int c, u32x4 (&P)[14], u32x4 (&Z)[2]) __attribute__((always_inline)) {
            SC_STOREX((c & 1) ^ 1, P);
            { const int c3 = c + 3 < 64 ? c + 3 : 63; SC_LOADX(c3, P); }
            ostage(c - 1, Z);
            { const int c1 = c + 1 < 64 ? c + 1 : 63; SC_LOADZ(c1, Z); }
            asm volatile("s_waitcnt lgkmcnt(0)" ::: "memory"); __builtin_amdgcn_s_barrier(); asm volatile("" ::: "memory");
        };
#pragma unroll 1
        for (int c = 1; c < 63; c += 2) { sstep(c, Y, ZA); sstep(c + 1, X, ZB); }
        sstep(63, Y, ZA);
        ostage(63, ZB);
#undef SC_LOADX
#undef SC_STOREX
#undef SC_LOADZ
    }
    __syncthreads();
}

__device__ __forceinline__ void moe_weight_items(LAS unsigned char* lds, const float* wgu, const float* wdn, bf16* WGU, bf16* WD, int w0, int nw, int lane, int wave) {
    LAS float* scr = (LAS float*)(lds + wave * 16384);
    f32x4 va[8], vb[8];
    int it = w0;
    if (it < TI_MOE) { const TDesc d = moe_desc(it, wgu, wdn, WGU, WD); t_load(d, lane, va); }
    while (it < TI_MOE) {
        const int nit = it + nw;
        if (nit < TI_MOE) { const TDesc dn = moe_desc(nit, wgu, wdn, WGU, WD); t_load(dn, lane, vb); }
        { const TDesc d = moe_desc(it, wgu, wdn, WGU, WD); t_store(d, va, scr, lane); }
#pragma unroll
        for (int q = 0; q < 8; ++q) va[q] = vb[q];
        it = nit;
    }
}

__global__ void __launch_bounds__(NTHREADS, 2) fwd(Args a) {
    extern __shared__ __attribute__((aligned(16))) unsigned char lds_raw[];
    LAS unsigned char* lds = (LAS unsigned char*)lds_raw;
    const int wave = __builtin_amdgcn_readfirstlane((int)threadIdx.x >> 6);
    const int G = gridDim.x;
#define PHASE_IDS int lane = hw_lane(); asm volatile("" : "+v"(lane)); const int tid = wave * 64 + lane; const int gt = blockIdx.x * NTHREADS + tid; (void)lane; (void)gt
    volatile LAS unsigned* LCTL = (volatile LAS unsigned*)(lds + LDSCTL_OFF);
    { PHASE_IDS; for (int u = tid; u < 256; u += NTHREADS) LCTL[u] = 0u; }
    __syncthreads();
    unsigned char* ws = a.ws;
    unsigned* ctl = (unsigned*)(ws + WS_CTL);
    XcdBarrier bar = xcd_barrier_post(ctl + CW_BAR, LCTL + 8, wave == 0);

    const float* x = a.in[I_X];
#define MODP ((float*)(a.ws + WS_OAOB))
#define MOD ((float*)(a.ws + WS_MOD))
#define WRH ((bf16*)(a.ws + WS_WRH))
#define WRL ((bf16*)(a.ws + WS_WRL))
#define WGU ((bf16*)(a.ws + WS_WGU))
#define WD ((bf16*)(a.ws + WS_WD))
#define U ((bf16*)(a.ws + WS_U))
#define ULO ((bf16*)(a.ws + WS_ULO))
#define HB ((bf16*)(a.ws + WS_H))
#define YB ((bf16*)(a.ws + WS_Y))
#define TOKLIST ((int*)(a.ws + WS_TOKLIST))
#define RI ((i32x4*)(a.ws + WS_RI))
#define RW ((f32x2*)(a.ws + WS_RW))
#define CNT ((unsigned*)(a.ws + WS_CTL) + CW_CNT)
#define WIN ((bf16*)(a.ws + WS_WIN))
#define WP ((bf16*)(a.ws + WS_WP))
#define WOUT ((bf16*)(a.ws + WS_WOUT))
#define WBD ((float*)(a.ws + WS_WBD))
#define BETA ((float*)(a.ws + WS_BG))
#define GG (BETA + (size_t)MTOK * 8)
#define HC ((bf16*)(a.ws + WS_HCAT))
#define OAOB ((bf16*)(a.ws + WS_OAOB))
#define MERGED ((bf16*)(a.ws + WS_MERGED))
    const int gw = blockIdx.x * NWAVES + wave, NGW = G * NWAVES;
    const int NGT = G * NTHREADS;

    {
        PHASE_IDS;
        LAS float* scr = (LAS float*)(lds + wave * 16384);
        for (int it = gw; it < 192 * MOD_KS; it += NGW) p0_mod_item(a.in[I_C], a.in[I_WADA], MODP, it, lane);
        {
            f32x4 va[8], vb[8];
            int it = gw;
            if (it < TI_P0) { const TDesc d = p0_desc(it, a.in[I_WIN], a.in[I_WPA], a.in[I_WPB], a.in[I_WOUT], WIN, WP, WOUT); t_load(d, lane, va); }
            while (it < TI_P0) {
                const int nit = it + NGW;
                if (nit < TI_P0) { const TDesc dn = p0_desc(nit, a.in[I_WIN], a.in[I_WPA], a.in[I_WPB], a.in[I_WOUT], WIN, WP, WOUT); t_load(dn, lane, vb); }
                { const TDesc d = p0_desc(it, a.in[I_WIN], a.in[I_WPA], a.in[I_WPB], a.in[I_WOUT], WIN, WP, WOUT); t_store(d, va, scr, lane); }
#pragma unroll
                for (int q = 0; q < 8; ++q) va[q] = vb[q];
                it = nit;
            }
        }
        for (int i = gt; i < 48 * D; i += NGT) { const int n = i / D, k = i - n * D;
            const float w = n < 32 ? a.in[I_WRE][(size_t)k * 32 + n] : (n < 36 ? a.in[I_WRG][(size_t)k * 4 + (n - 32)] : 0.f);
            const __bf16 hi = (__bf16)w; const float hf = (float)hi; const __bf16 lo = (__bf16)(w - hf);
            WRH[i] = __builtin_bit_cast(unsigned short, hi); WRL[i] = __builtin_bit_cast(unsigned short, lo); }
        for (int i = gt; i < 16 * D; i += NGT) { const int c = i / D, k = i - c * D; WBD[i] = a.in[I_WIN][(size_t)k * IN_W + 5632 + c]; }
    }
    xcd_barrier(bar);
    {
    PHASE_IDS;
    for (int i = gt; i < 4 * 6 * D; i += NGT) { const int n = i % (6 * D);
        MOD[i] = mod_sum(MODP, (size_t)i) + a.in[I_BADA][n]; }
    {
        LAS float* VEC = (LAS float*)lds;
        LAS float* WL = (LAS float*)(lds + 16384);
        for (int i = tid; i < 16 * D; i += NTHREADS) WL[i] = WBD[i];
        for (int grp = blockIdx.x; grp < MTOK / 64; grp += G) {
            const int b = (grp * 64) / SEQ;
            __syncthreads();
            for (int i = tid; i < 2 * D; i += NTHREADS) { const int n = i < D ? D + i : i - D; const size_t o = (size_t)b * 6 * D + n;
                const float v = mod_sum(MODP, o) + a.in[I_BADA][n];
                VEC[i] = i < D ? 1.f + v : v; }
            __syncthreads();
            const int mb = grp * 64 + wave * 8;
            f32x4 cur[2][8], nxt[2][8];
#pragma unroll
            for (int q = 0; q < 2; ++q) { const f32x4* xr = (const f32x4*)(x + (size_t)(mb + q) * D) + lane;
#pragma unroll
                for (int j = 0; j < 8; ++j) cur[q][j] = xr[64 * j]; }
#pragma unroll 1
            for (int rr = 0; rr < 8; rr += 2) {
                const int mn = mb + (rr + 2 < 8 ? rr + 2 : rr);
#pragma unroll
                for (int q = 0; q < 2; ++q) { const f32x4* xr = (const f32x4*)(x + (size_t)(mn + q) * D) + lane;
#pragma unroll
                    for (int j = 0; j < 8; ++j) nxt[q][j] = xr[64 * j]; }
                ln_norm(cur[0], lane); ln_norm(cur[1], lane);
#pragma unroll
                for (int j = 0; j < 8; ++j) { const f32x4 sc = *(const LAS f32x4*)(VEC + 4 * lane + 256 * j), sh = *(const LAS f32x4*)(VEC + D + 4 * lane + 256 * j);
#pragma unroll
                    for (int q = 0; q < 2; ++q) { cur[q][j] = cur[q][j] * sc + sh;
                        ((unsigned*)((unsigned char*)U + (size_t)(mb + rr + q) * D) + lane)[64 * j] = pk_fp8x4(cur[q][j][0], cur[q][j][1], cur[q][j][2], cur[q][j][3]); } }
                float mine0 = 0.f, mine1 = 0.f;
#pragma unroll 1
                for (int c = 0; c < 16; ++c) { float a0 = 0.f, a1 = 0.f;
                    asm volatile("" ::: "memory");
#pragma unroll
                    for (int j = 0; j < 8; ++j) { const f32x4 w = *(const LAS f32x4*)(WL + c * D + 4 * lane + 256 * j);
                        a0 += (cur[0][j][0] * w[0] + cur[0][j][1] * w[1]) + (cur[0][j][2] * w[2] + cur[0][j][3] * w[3]);
                        a1 += (cur[1][j][0] * w[0] + cur[1][j][1] * w[1]) + (cur[1][j][2] * w[2] + cur[1][j][3] * w[3]); }
#pragma unroll
                    for (int o = 1; o < 64; o <<= 1) { a0 += shx(a0, o, lane); a1 += shx(a1, o, lane); }
                    mine0 = (lane == c) ? a0 : mine0; mine1 = (lane == c) ? a1 : mine1; }
#pragma unroll
                for (int q = 0; q < 2; ++q) { const float mine = q ? mine1 : mine0; const size_t m = (size_t)(mb + rr + q);
                    if (lane < 8) BETA[m * 8 + lane] = sigmoidf_(mine);
                    else if (lane < 16) { const int hh = lane - 8; const float z = mine + a.in[I_DTB][hh]; const float sp = z > 20.f ? z : log1pf(__expf(z)); GG[m * 8 + hh] = -__expf(a.in[I_ALOG][hh]) * sp; } }
#pragma unroll
                for (int q = 0; q < 2; ++q)
#pragma unroll
                    for (int j = 0; j < 8; ++j) cur[q][j] = nxt[q][j];
            }
        }
    }
    }
    xcd_barrier(bar);
    {
        pg8::StaticOrder S; S.init(U, WIN, MTOK, HC_W, D / 2, G, blockIdx.x);
        pg8::EpiHcat E{HC, 1.f / 64.f};
        { const int nwg = (MTOK / 256) * (HC_W / 256), first = nwg % G;
          if (first != 0 && (int)blockIdx.x >= first) { const int pop = ((int)blockIdx.x - first) * 3 / (G - first);
              for (int i = 0; i < 2 * (pop + 1); ++i) __builtin_amdgcn_s_sleep(127); } }
        pg8::gemm_phase<pg8::EpiHcat, pg8::StaticOrder, false, false, true>(lds, S, E, wave);
    }
    xcd_barrier(bar);
    {
        PHASE_IDS;
        float* DECS = BETA + (size_t)MTOK * 16;
        for (int ug = blockIdx.x; ug < 256; ug += G) gdn_pre(lds, HC, a.in[I_CONVW], BETA, GG, ws + WS_GDN, ws + WS_MERGED, DECS, ug, tid, lane, wave);
    }
    xcd_barrier(bar);
    {
        PHASE_IDS;
        const float* DECS = BETA + (size_t)MTOK * 16;
        float* SSQ = (float*)(ws + WS_MODP);
        const int nsc = G > 128 ? 64 : 0;
        if (nsc) {
            if ((int)blockIdx.x < nsc) gdn_scan(lds, ws + WS_GDN, DECS, HC, a.in[I_NORMW], OAOB, SSQ, blockIdx.x >> 1, blockIdx.x & 1, tid, lane, wave);
            else {
                for (int unit = blockIdx.x - nsc; unit < BATCH * 64 * 4; unit += G - nsc) swa_unit(lds, HC, (bf16*)(ws + WS_U + 32 * MiB), a.in[I_SINKS], unit, tid, lane, wave);
                __syncthreads();
                moe_weight_items(lds, a.in[I_WGU], a.in[I_WDN], WGU, WD, (blockIdx.x - nsc) * NWAVES + wave, (G - nsc) * NWAVES, lane, wave);
            }
        } else {
            for (int w = blockIdx.x; w < 64; w += G) gdn_scan(lds, ws + WS_GDN, DECS, HC, a.in[I_NORMW], OAOB, SSQ, w >> 1, w & 1, tid, lane, wave);
            for (int unit = blockIdx.x; unit < BATCH * 64 * 4; unit += G) swa_unit(lds, HC, (bf16*)(ws + WS_U + 32 * MiB), a.in[I_SINKS], unit, tid, lane, wave);
            __syncthreads();
            moe_weight_items(lds, a.in[I_WGU], a.in[I_WDN], WGU, WD, blockIdx.x * NWAVES + wave, G * NWAVES, lane, wave);
        }
    }
    xcd_barrier(bar);
    {
        PHASE_IDS;
        const float* SSQ = (const float*)(ws + WS_MODP);
        unsigned char* OAOB8 = ws + WS_U + 32 * MiB;
        const int gw2 = blockIdx.x * NWAVES + wave;
        for (int m = gw2; m < MTOK; m += G * NWAVES) {
            const int hh = lane >> 3;
            const float rstd = rsqrtf((SSQ[(size_t)m * 8 + hh] + SSQ[((size_t)MTOK + m) * 8 + hh]) * (1.f / 128.f) + 1e-6f);
            const u32x4* pp = (const u32x4*)(OAOB + (size_t)m * D + 1024 + 16 * lane);
            const u32x4 v0 = pp[0], v1 = pp[1];
            const float r4 = fminf(4.f * rstd, 3.0e38f);
#define P4B_C(x) fminf(fmaxf((x) * r4, -440.f), 440.f)
            u32x4 w;
            w.x = pk_fp8x4(P4B_C(bflo(v0.x)), P4B_C(bfhi(v0.x)), P4B_C(bflo(v0.y)), P4B_C(bfhi(v0.y))); w.y = pk_fp8x4(P4B_C(bflo(v0.z)), P4B_C(bfhi(v0.z)), P4B_C(bflo(v0.w)), P4B_C(bfhi(v0.w)));
            w.z = pk_fp8x4(P4B_C(bflo(v1.x)), P4B_C(bfhi(v1.x)), P4B_C(bflo(v1.y)), P4B_C(bfhi(v1.y))); w.w = pk_fp8x4(P4B_C(bflo(v1.z)), P4B_C(bfhi(v1.z)), P4B_C(bflo(v1.w)), P4B_C(bfhi(v1.w)));
#undef P4B_C
            *(u32x4*)(OAOB8 + (size_t)m * D + 1024 + 16 * lane) = w;
        }
    }
    xcd_barrier(bar);
    {
        pg8::StaticOrder S; S.init(ws + WS_U + 32 * MiB, WP, MTOK, D, D / 2, G, blockIdx.x, 8);
        pg8::EpiMerged E{HC, MERGED};
        pg8::gemm_phase<pg8::EpiMerged, pg8::StaticOrder, false, true, true>(lds, S, E, wave);
    }
    xcd_barrier(bar);
    {
        pg8::StaticOrder S; S.init(MERGED, WOUT, MTOK, D, D / 2, G, blockIdx.x, 8);
        pg8::EpiMixG E{MOD, OAOB, 1.f / 2048.f};
        pg8::gemm_phase<pg8::EpiMixG, pg8::StaticOrder, false, false, true>(lds, S, E, wave);
    }
    xcd_barrier(bar);

    {
        PHASE_IDS;
        LAS float* VEC = (LAS float*)lds;
        LAS float* PART = (LAS float*)(lds + 32768);
        LAS float* LOGIT = (LAS float*)(lds + 32768 + 98304);
        LAS int* CNTL = (LAS int*)(lds + 32768 + 98304 + 12288);
        for (int grp = blockIdx.x; grp < MTOK / 64; grp += G) {
            const int b = (grp * 64) / SEQ;
            __syncthreads();
            for (int i = tid; i < D; i += NTHREADS) { VEC[i] = a.in[I_LN1G][i]; VEC[D + i] = a.in[I_LN1B][i]; VEC[2 * D + i] = 1.f + MOD[(size_t)b * 6 * D + 4 * D + i]; VEC[3 * D + i] = MOD[(size_t)b * 6 * D + 3 * D + i]; }
            __syncthreads();
            const int r0 = grp * 64 + wave * 8;
            {
                f32x4 cur[8], nx[8]; u32x2 nm[8];
#define P7_LOADROW(m_) do { const f32x4* _xr = (const f32x4*)(x + (size_t)(m_) * D) + lane; const u32x2* _mr = (const u32x2*)(OAOB + (size_t)(m_) * D) + lane; \
                    _Pragma("unroll") for (int j = 0; j < 8; ++j) { nx[j] = _xr[64 * j]; nm[j] = _mr[64 * j]; } } while (0)
#define P7_TAKEROW() do { _Pragma("unroll") for (int j = 0; j < 8; ++j) cur[j] = nx[j] * ALPHA + (f32x4){bflo(nm[j].x), bfhi(nm[j].x), bflo(nm[j].y), bfhi(nm[j].y)}; } while (0)
                P7_LOADROW(r0); P7_TAKEROW();
#pragma unroll 1
                for (int rr = 0; rr < 8; ++rr) {
                    const int m = r0 + rr;
                    P7_LOADROW((rr + 1 < 8 ? m + 1 : m));
                    asm volatile("" ::: "memory");
                    u32x2* o = (u32x2*)((bf16*)(a.ws + WS_GDN) + (size_t)m * D) + lane;
                    ln_norm(cur, lane);
#pragma unroll
                    for (int j = 0; j < 8; ++j) { const f32x4 gg = *(const LAS f32x4*)(VEC + 4 * lane + 256 * j), bb = *(const LAS f32x4*)(VEC + D + 4 * lane + 256 * j); cur[j] = cur[j] * gg + bb; u32x2 w1; w1.x = pk2(cur[j][0], cur[j][1]); w1.y = pk2(cur[j][2], cur[j][3]); o[64 * j] = w1; }
                    ln_norm(cur, lane);
                    u32x2* ul = (u32x2*)(ULO + (size_t)m * D) + lane;
#pragma unroll
                    for (int j = 0; j < 8; ++j) { const f32x4 sc = *(const LAS f32x4*)(VEC + 2 * D + 4 * lane + 256 * j), sh = *(const LAS f32x4*)(VEC + 3 * D + 4 * lane + 256 * j);
                        const f32x4 t = cur[j] * sc + sh;
                        const unsigned p8 = pk_fp8x4(t[0], t[1], t[2], t[3]);
                        const f32x2 d0 = __builtin_amdgcn_cvt_pk_f32_fp8(p8, false), d1 = __builtin_amdgcn_cvt_pk_f32_fp8(p8, true);
                        u32x2 l; l.x = pk2(t[0] - d0[0], t[1] - d0[1]); l.y = pk2(t[2] - d1[0], t[3] - d1[1]);
                        ul[64 * j] = l; ((unsigned*)(a.ws + WS_MERGED + (size_t)m * D) + lane)[64 * j] = p8; }
                    P7_TAKEROW();
                }
            }
#undef P7_TAKEROW
#undef P7_LOADROW
            VM_WAIT();
            __syncthreads();
            {
                const int fr = lane & 15, fq = lane >> 4;
                f32x4 cacc[4][3];
#pragma unroll
                for (int mt = 0; mt < 4; ++mt)
#pragma unroll
                    for (int nt = 0; nt < 3; ++nt) cacc[mt][nt] = (f32x4){0.f, 0.f, 0.f, 0.f};
                const size_t g0 = (size_t)grp * 64;
                const unsigned char* a8 = a.ws + WS_MERGED + (g0 + fr) * D + 256 * wave + 8 * fq; const bf16* al = ULO + (g0 + fr) * D + 256 * wave + 8 * fq;
                const bf16* bh = WRH + (size_t)fr * D + 256 * wave + 8 * fq; const bf16* bl = WRL + (size_t)fr * D + 256 * wave + 8 * fq;
#pragma unroll 2
                for (int sx = 0; sx < 8; ++sx) {
                    bf16x8 Ah[4], Al[4], Bh[3], Bl[3];
#pragma unroll
                    for (int mt = 0; mt < 4; ++mt) { const u32x2 q8 = *(const u32x2*)(a8 + (size_t)mt * 16 * D + 32 * sx);
                        const f32x2 e0 = __builtin_amdgcn_cvt_pk_f32_fp8(q8.x, false), e1 = __builtin_amdgcn_cvt_pk_f32_fp8(q8.x, true), e2 = __builtin_amdgcn_cvt_pk_f32_fp8(q8.y, false), e3 = __builtin_amdgcn_cvt_pk_f32_fp8(q8.y, true);
                        u32x4 hw; hw.x = pk2(e0[0], e0[1]); hw.y = pk2(e1[0], e1[1]); hw.z = pk2(e2[0], e2[1]); hw.w = pk2(e3[0], e3[1]);
                        Ah[mt] = __builtin_bit_cast(bf16x8, hw); Al[mt] = *(const bf16x8*)(al + (size_t)mt * 16 * D + 32 * sx); }
#pragma unroll
                    for (int nt = 0; nt < 3; ++nt) { Bh[nt] = *(const bf16x8*)(bh + (size_t)nt * 16 * D + 32 * sx); Bl[nt] = *(const bf16x8*)(bl + (size_t)nt * 16 * D + 32 * sx); }
#pragma unroll
                    for (int mt = 0; mt < 4; ++mt)
#pragma unroll
                        for (int nt = 0; nt < 3; ++nt) {
                            cacc[mt][nt] = __builtin_amdgcn_mfma_f32_16x16x32_bf16(Ah[mt], Bh[nt], cacc[mt][nt], 0, 0, 0);
                            cacc[mt][nt] = __builtin_amdgcn_mfma_f32_16x16x32_bf16(Al[mt], Bh[nt], cacc[mt][nt], 0, 0, 0);
                            cacc[mt][nt] = __builtin_amdgcn_mfma_f32_16x16x32_bf16(Ah[mt], Bl[nt], cacc[mt][nt], 0, 0, 0);
                        }
                }
#pragma unroll
                for (int mt = 0; mt < 4; ++mt)
#pragma unroll
                    for (int nt = 0; nt < 3; ++nt)
#pragma unroll
                        for (int jx = 0; jx < 4; ++jx) PART[(wave * 64 + 16 * mt + 4 * fq + jx) * 48 + 16 * nt + fr] = cacc[mt][nt][jx];
            }
            if (tid < 64) CNTL[tid] = 0;
            __syncthreads();
            for (int idx = tid; idx < 64 * 48; idx += NTHREADS) { float sacc = 0.f;
#pragma unroll
                for (int w8 = 0; w8 < 8; ++w8) sacc += PART[w8 * 64 * 48 + idx];
                LOGIT[idx] = sacc; }
            __syncthreads();
            int e0 = 0, e1 = 0, rk0 = 0, rk1 = 0; float w0 = 0.f, w1 = 0.f;
            if (tid < 64) {
                const LAS float* lg = LOGIT + tid * 48;
                float gl[4]; float gmax = -3.0e38f; int gi = 0;
#pragma unroll
                for (int jx = 0; jx < 4; ++jx) { gl[jx] = lg[32 + jx] + a.in[I_BRG][jx]; if (gl[jx] > gmax) { gmax = gl[jx]; gi = jx; } }
                float gs = 0.f;
#pragma unroll
                for (int jx = 0; jx < 4; ++jx) gs += __expf(gl[jx] - gmax);
                const float pg = 1.f / gs;
                float el[8]; float emax = -3.0e38f; int i0 = 0;
#pragma unroll
                for (int jx = 0; jx < 8; ++jx) { el[jx] = lg[8 * gi + jx] + a.in[I_BRE][8 * gi + jx]; if (el[jx] > emax) { emax = el[jx]; i0 = jx; } }
                float e2 = -3.0e38f; int i1 = 0;
#pragma unroll
                for (int jx = 0; jx < 8; ++jx) { if (jx != i0 && el[jx] > e2) { e2 = el[jx]; i1 = jx; } }
                const float p1r = __expf(e2 - emax);
                const float t0 = 1.f / (1.f + p1r), t1 = p1r * t0;
                e0 = 8 * gi + i0; e1 = 8 * gi + i1; w0 = pg * t0; w1 = pg * t1;
                rk0 = __hip_atomic_fetch_add(CNTL + e0, 1, __ATOMIC_RELAXED, __HIP_MEMORY_SCOPE_WORKGROUP);
                rk1 = __hip_atomic_fetch_add(CNTL + e1, 1, __ATOMIC_RELAXED, __HIP_MEMORY_SCOPE_WORKGROUP);
            }
            __syncthreads();
            if (tid < 32) { const int cn = CNTL[tid]; CNTL[32 + tid] = cn ? (int)atomicAdd(CNT + 64 * tid, (unsigned)cn) : 0; }
            __syncthreads();
            if (tid < 64) {
                const int m = grp * 64 + tid, pos0 = CNTL[32 + e0] + rk0, pos1 = CNTL[32 + e1] + rk1;
                TOKLIST[(size_t)e0 * MTOK + pos0] = m; TOKLIST[(size_t)e1 * MTOK + pos1] = m;
                RI[m] = (i32x4){e0, pos0, e1, pos1}; RW[m] = (f32x2){w0, w1};
            }
        }
    }
    xcd_barrier(bar);

    volatile LAS int* TB = (volatile LAS int*)(LCTL + 16);
    if (wave == 0 && hw_lane() == 0) { int acc = 0; for (int e = 0; e < NEXP; ++e) { const int c = (int)__hip_atomic_load(CNT + 64 * e, __ATOMIC_RELAXED, __HIP_MEMORY_SCOPE_AGENT); TB[e] = acc; TB[33 + e] = c; acc += (c + 255) >> 8; } TB[32] = acc; }
    __syncthreads();

    {
        pg8::MoeOrder S; S.A = (const char*)(a.ws + WS_MERGED); S.Bt = (const char*)WGU; S.K = D / 2; S.b_estride = (size_t)1024 * D; S.toklist = TOKLIST; S.tb = TB; S.ncol = 4; S.G = G; S.c = blockIdx.x;
        pg8::EpiGateUp E{HB, 1.f / 64.f};
        pg8::gemm_phase<pg8::EpiGateUp, pg8::MoeOrder, true, false, true>(lds, S, E, wave);
    }
    xcd_barrier(bar);
    {
        pg8::MoeOrder S; S.A = (const char*)HB; S.Bt = (const char*)WD; S.K = EFF / 2; S.b_estride = (size_t)D * EFF; S.toklist = nullptr; S.tb = TB; S.ncol = 8; S.G = G; S.c = blockIdx.x;
        pg8::EpiBf16 E{(unsigned char*)YB, D, 64.f / 512.f};
        pg8::gemm_phase<pg8::EpiBf16, pg8::MoeOrder, false, false, true>(lds, S, E, wave);
    }
    xcd_barrier(bar);
    {
        PHASE_IDS;
        LAS float* VEC = (LAS float*)lds;
        for (int grp = blockIdx.x; grp < MTOK / 64; grp += G) {
            const int b = (grp * 64) / SEQ;
            __syncthreads();
            for (int i = tid; i < D; i += NTHREADS) { VEC[i] = a.in[I_LN2G][i]; VEC[D + i] = a.in[I_LN2B][i]; VEC[2 * D + i] = MOD[(size_t)b * 6 * D + 5 * D + i]; }
            __syncthreads();
            {
                const int mb = grp * 64 + wave * 8;
#define P10_ISSUE(ri_, m_, X_, Y0_, Y1_) do { const int _s0 = 256 * TB[(ri_).x] + (ri_).y, _s1 = 256 * TB[(ri_).z] + (ri_).w; \
                    const u32x2* _o = (const u32x2*)((const bf16*)(a.ws + WS_GDN) + (size_t)(m_) * D) + lane; const unsigned* _y0 = (const unsigned*)((const unsigned char*)YB + (size_t)_s0 * D) + lane; const unsigned* _y1 = (const unsigned*)((const unsigned char*)YB + (size_t)_s1 * D) + lane; \
                    _Pragma("unroll") for (int j = 0; j < 8; ++j) { X_[j] = _o[64 * j]; Y0_[j] = _y0[64 * j]; Y1_[j] = _y1[64 * j]; } } while (0)
                i32x4 riB = RI[mb + 1], riC; f32x2 rwA = RW[mb], rwB = RW[mb + 1], rwC;
                u32x2 cx[8], nx[8]; unsigned cy0[8], cy1[8], ny0[8], ny1[8];
                { const i32x4 riA = RI[mb]; P10_ISSUE(riA, mb, cx, cy0, cy1); }
#pragma unroll 1
                for (int rr = 0; rr < 8; ++rr) {
                    const int m = mb + rr, m1 = mb + (rr + 1 < 8 ? rr + 1 : 7), m2 = mb + (rr + 2 < 8 ? rr + 2 : 7);
                    riC = RI[m2]; rwC = RW[m2];
                    P10_ISSUE(riB, m1, nx, ny0, ny1);
                    asm volatile("" ::: "memory");
                    f32x4 v[8];
#pragma unroll
                    for (int j = 0; j < 8; ++j) {
                        const f32x2 p0 = __builtin_amdgcn_cvt_pk_f32_fp8(cy0[j], false), p1 = __builtin_amdgcn_cvt_pk_f32_fp8(cy0[j], true), q0 = __builtin_amdgcn_cvt_pk_f32_fp8(cy1[j], false), q1 = __builtin_amdgcn_cvt_pk_f32_fp8(cy1[j], true);
                        const float w0 = rwA.x * (1.f / 64.f), w1 = rwA.y * (1.f / 64.f);
                        const f32x4 f = {w0 * p0[0] + w1 * q0[0], w0 * p0[1] + w1 * q0[1], w0 * p1[0] + w1 * q1[0], w0 * p1[1] + w1 * q1[1]};
                        const f32x4 g2 = *(const LAS f32x4*)(VEC + 2 * D + 4 * lane + 256 * j);
                        v[j] = (f32x4){bflo(cx[j].x), bfhi(cx[j].x), bflo(cx[j].y), bfhi(cx[j].y)} * ALPHA + g2 * f;
                    }
                    ln_norm(v, lane);
                    f32x4* o = (f32x4*)(a.out + (size_t)m * D) + lane;
#pragma unroll
                    for (int j = 0; j < 8; ++j) { const f32x4 gg = *(const LAS f32x4*)(VEC + 4 * lane + 256 * j), bb = *(const LAS f32x4*)(VEC + D + 4 * lane + 256 * j); o[64 * j] = v[j] * gg + bb; }
#pragma unroll
                    for (int j = 0; j < 8; ++j) { cx[j] = nx[j]; cy0[j] = ny0[j]; cy1[j] = ny1[j]; }
                    rwA = rwB; riB = riC; rwB = rwC;
                }
#undef P10_ISSUE
            }
        }
    }
}

#undef MODP
#undef MOD
#undef WRH
#undef WRL
#undef WGU
#undef WD
#undef U
#undef ULO
#undef HB
#undef YB
#undef TOKLIST
#undef RI
#undef RW
#undef CNT
#undef WIN
#undef WP
#undef WOUT
#undef WBD
#undef BETA
#undef GG
#undef HC
#undef OAOB
#undef MERGED

extern "C" void kernel_launch(void* const* d_in, const int* in_sizes, int n_in, void* d_out, int out_size, void* d_ws, size_t ws_size, hipStream_t stream) {
    static int grid = 0;
    if (grid == 0) {
        int dev = 0, cus = 0, per_cu = 0;
        if (n_in != 23 || out_size != MTOK * D || ws_size < WS_END) { fprintf(stderr, "kernel_launch: unexpected shapes (n_in %d out %d ws %zu)\n", n_in, out_size, ws_size); grid = -1; return; }
        if (hipGetDevice(&dev) != hipSuccess || hipDeviceGetAttribute(&cus, hipDeviceAttributeMultiprocessorCount, dev) != hipSuccess) { grid = -1; return; }
        if (hipFuncSetAttribute((const void*)fwd, hipFuncAttributeMaxDynamicSharedMemorySize, LDS_BYTES) != hipSuccess) { fprintf(stderr, "hipFuncSetAttribute failed\n"); grid = -1; return; }
        if (hipOccupancyMaxActiveBlocksPerMultiprocessor(&per_cu, (const void*)fwd, NTHREADS, LDS_BYTES) != hipSuccess || per_cu < 1) fprintf(stderr, "occupancy query says %d\n", per_cu);
        (void)hipGetLastError();
        grid = cus;
    }
    if (grid < 0) return;
    (void)hipMemsetAsync((char*)d_ws + WS_CTL, 0, CTL_ZERO_BYTES, stream);
    Args a{};
    for (int i = 0; i < 23; ++i) a.in[i] = (const float*)d_in[i];
    a.out = (float*)d_out; a.ws = (unsigned char*)d_ws;
    hipLaunchKernelGGL(fwd, dim3(grid), dim3(NTHREADS), LDS_BYTES, stream, a);
}
```

```cpp
#include <hip/hip_runtime.h>
#include <cstdio>
#include <cstdint>

#define LAS __attribute__((address_space(3)))
typedef unsigned short bf16;
typedef short bf16x8 __attribute__((ext_vector_type(8)));
typedef float f32x4 __attribute__((ext_vector_type(4)));
typedef float f32x2 __attribute__((ext_vector_type(2)));
typedef float f32x16 __attribute__((ext_vector_type(16)));
typedef unsigned u32x4 __attribute__((ext_vector_type(4)));
typedef unsigned u32x2 __attribute__((ext_vector_type(2)));
typedef int i32x4 __attribute__((ext_vector_type(4)));
typedef __bf16 bf16x2_t __attribute__((ext_vector_type(2)));
typedef int i32x8 __attribute__((ext_vector_type(8)));

constexpr int NWAVES = 8, NTHREADS = 512;
constexpr int D = 2048, BATCH = 4, SEQ = 4096, MTOK = BATCH * SEQ;
constexpr int NEXP = 32, EFF = 512;
constexpr int IN_W = 9744, HC_W = 9728;
constexpr float LN_EPS = 1e-5f;
constexpr float ALPHA = 1.189207115002721f;
constexpr int MOE_ROWS = 40960;

constexpr size_t MiB = 1u << 20;
constexpr size_t WS_CTL = 0, CTL_ZERO_BYTES = 128 * 1024;
constexpr size_t WS_MODP = 1 * MiB;
constexpr size_t WS_MOD = 2 * MiB;
constexpr size_t WS_WBD = 2 * MiB + 256 * 1024;
constexpr size_t WS_WRH = 2 * MiB + 512 * 1024;
constexpr size_t WS_WRL = 2 * MiB + 768 * 1024;
constexpr size_t WS_RI = 3 * MiB;
constexpr size_t WS_RW = 3 * MiB + 512 * 1024;
constexpr size_t WS_TOKLIST = 4 * MiB;
constexpr size_t WS_BG = 6 * MiB;
constexpr size_t WS_WIN = 8 * MiB;
constexpr size_t WS_WP = 46 * MiB;
constexpr size_t WS_WOUT = 54 * MiB;
constexpr size_t WS_WGU = 62 * MiB;
constexpr size_t WS_WD = 190 * MiB;
constexpr size_t WS_U = 254 * MiB;
constexpr size_t WS_OAOB = 318 * MiB;
constexpr size_t WS_MERGED = 382 * MiB;
constexpr size_t WS_GDN = 446 * MiB;
constexpr size_t WS_HCAT = 590 * MiB;
constexpr size_t WS_H = WS_HCAT;
constexpr size_t WS_Y = WS_HCAT + 40 * MiB;
constexpr size_t WS_ULO = WS_HCAT + 200 * MiB;
constexpr size_t WS_END = 894 * MiB;
constexpr int CW_BAR = 4096;
constexpr int CW_RT = 16384;
constexpr int CW_CNT = 8192;

constexpr int SCRATCH_BYTES = 157696;
constexpr int LDSCTL_OFF = SCRATCH_BYTES;
constexpr int LDS_BYTES = SCRATCH_BYTES + 1024;

#define LDS_WAIT() asm volatile("s_waitcnt lgkmcnt(0)" ::: "memory")
#define VM_WAIT() asm volatile("s_waitcnt vmcnt(0)" ::: "memory")

__device__ __forceinline__ unsigned pk2(float lo, float hi) { bf16x2_t v; v.x = (__bf16)lo; v.y = (__bf16)hi; return __builtin_bit_cast(unsigned, v); }
__device__ __forceinline__ unsigned pk_fp8x4(float a, float b, float c, float d) { int w = 0; w = __builtin_amdgcn_cvt_pk_fp8_f32(a, b, w, false); w = __builtin_amdgcn_cvt_pk_fp8_f32(c, d, w, true); return (unsigned)w; }
__device__ __forceinline__ float bf2f(unsigned short b) { return __uint_as_float(((unsigned)b) << 16); }
__device__ __forceinline__ float bflo(unsigned w) { return __uint_as_float(w << 16); }
__device__ __forceinline__ float bfhi(unsigned w) { return __uint_as_float(w & 0xffff0000u); }
__device__ __forceinline__ float sigmoidf_(float x) { return __builtin_amdgcn_rcpf(1.f + __expf(-x)); }
__device__ __forceinline__ float siluf_(float x) { return x * __builtin_amdgcn_rcpf(1.f + __expf(-x)); }

__device__ __forceinline__ int hw_lane() { int l; asm volatile("v_mbcnt_lo_u32_b32 %0, -1, 0\n\tv_mbcnt_hi_u32_b32 %0, -1, %0" : "=v"(l)); return l; }
#define XB_TMO      128
#define XB_XCNT(j)  (256  + 64 * (j))
#define XB_XSUB(j)  (1280 + 64 * (j))
#define XB_XGEN(j)  (2304 + 64 * (j))
#define XB_TOP      3328
#define XB_TOPGEN   3392
#define XCD_BAR_WORDS 3456
#define XB_SPIN_CAP (1u << 18)

__device__ __forceinline__ unsigned xb_ld(unsigned* p)              { return __hip_atomic_load(p, __ATOMIC_RELAXED, __HIP_MEMORY_SCOPE_AGENT); }
__device__ __forceinline__ unsigned xb_add(unsigned* p, unsigned v) { return __hip_atomic_fetch_add(p, v, __ATOMIC_RELAXED, __HIP_MEMORY_SCOPE_AGENT); }
__device__ __forceinline__ unsigned xb_xcc_id() { return (unsigned)__builtin_amdgcn_s_getreg((3 << 11) | 20) & 0xFu; }
#define XB_SPIN(cond, bar) do { unsigned _sp = 0; while (cond) { __builtin_amdgcn_s_sleep(1); \
    if ((++_sp & 255u) == 0u) { if (xb_ld(&(bar)[XB_TMO])) break; if (_sp > XB_SPIN_CAP) { atomicAdd(&(bar)[XB_TMO], 1u); break; } } } } while (0)

struct XcdBarrier { unsigned* bar; unsigned x; volatile LAS unsigned* st; bool wave0; };

__device__ __forceinline__ XcdBarrier xcd_barrier_post(unsigned* bar, volatile LAS unsigned* st, bool wave0) {
    XcdBarrier b; b.bar = bar; b.x = xb_xcc_id(); b.st = st; b.wave0 = wave0;
    if (wave0 && hw_lane() == 0) (void)xb_add(&bar[XB_XCNT(b.x)], 1u);
    return b;
}
__device__ __forceinline__ void xcd_barrier_complete(unsigned* bar, unsigned x, unsigned& nloc, unsigned& nx) {
    const unsigned G = gridDim.x * gridDim.y * gridDim.z;
    unsigned sum, cnt, mine, sp = 0u;
    for (;;) {
        sum = 0u; cnt = 0u; mine = 0u;
#pragma unroll
        for (unsigned j = 0; j < 16; ++j) { const unsigned c = xb_ld(&bar[XB_XCNT(j)]); sum += c; cnt += (c > 0u) ? 1u : 0u; mine = (j == x) ? c : mine; }
        if (sum == G) break;
        __builtin_amdgcn_s_sleep(1);
        if ((++sp & 255u) == 0u) { if (xb_ld(&bar[XB_TMO])) break; if (sp > XB_SPIN_CAP) { atomicAdd(&bar[XB_TMO], 1u); break; } }
    }
    nloc = mine > 0u ? mine : 1u; nx = cnt > 0u ? cnt : 1u;
}
__device__ __forceinline__ void xcd_barrier(const XcdBarrier& b) {
    asm volatile("s_waitcnt vmcnt(0)" ::: "memory");
    __syncthreads();
    if (b.wave0 && hw_lane() == 0) {
        unsigned* bar = b.bar;
        __builtin_amdgcn_s_waitcnt(0);
        unsigned nloc = b.st[0], nx = b.st[1];
        if (nloc == 0u) { xcd_barrier_complete(bar, b.x, nloc, nx); b.st[0] = nloc; b.st[1] = nx; }
        const unsigned old = xb_add(&bar[XB_XSUB(b.x)], 1u);
        const unsigned gen = old / nloc;
        if (old + 1u == (gen + 1u) * nloc) {
            __builtin_amdgcn_fence(__ATOMIC_RELEASE, "agent");
            asm volatile("s_waitcnt vmcnt(0)" ::: "memory");
            const unsigned og = xb_add(&bar[XB_TOP], 1u);
            const unsigned tg = og / nx;
            if (og + 1u == (tg + 1u) * nx) xb_add(&bar[XB_TOPGEN], 1u);
            else XB_SPIN(xb_ld(&bar[XB_TOPGEN]) == tg, bar);
            __builtin_amdgcn_fence(__ATOMIC_ACQUIRE, "agent");
            xb_add(&bar[XB_XGEN(b.x)], 1u);
            asm volatile("s_waitcnt vmcnt(0)" ::: "memory");
        } else {
            XB_SPIN(xb_ld(&bar[XB_XGEN(b.x)]) == gen, bar);
            __builtin_amdgcn_fence(__ATOMIC_ACQUIRE, "agent");
            asm volatile("s_waitcnt vmcnt(0)" ::: "memory");
        }
    }
    __syncthreads();
}

namespace pg8 {
constexpr int BM = 256, BK = 64, HALF = 128, HTB = HALF * BK * 2, STAGE_BYTES = 8 * HTB, NXCD = 8, WGM = 2;
__host__ __device__ __forceinline__ int lds_byte(int r, int c) { const int st = (r >> 4) * 2 + (c >> 5), rr = r & 15, cc = c & 31, ob = rr * 64 + cc * 2; return st * 1024 + (ob ^ (((ob >> 9) & 1) << 5)); }
__host__ __device__ __forceinline__ void stage_rc(int b, int& R, int& C) { const int st = b / 1024, sb = b % 1024, swz = sb ^ (((sb >> 9) & 1) << 5); R = (st >> 1) * 16 + swz / 64; C = (st & 1) * 32 + (swz % 64) / 2; }
__host__ __device__ __forceinline__ int perm32(int rho) { const int n = rho >> 4, i = rho & 15; return 8 * (i >> 2) + 4 * n + (i & 3); }

struct Unit { int pm, pn, e, r0, nrows; };

struct StaticOrder {
    const char* A; const char* Bt; int K;
    int nM, nN, nwg, G, c, wgm;
    __device__ void init(const void* A_, const void* Bt_, int M, int N, int K_, int G_, int c_, int wgm_ = WGM) { A = (const char*)A_; Bt = (const char*)Bt_; K = K_; nM = M / BM; nN = N / BM; nwg = nM * nN; G = G_; c = c_; wgm = wgm_; }
    __device__ bool next(int i, Unit& u) const {
        const long L = (long)i * G + c; if (L >= nwg) return false;
        int wgid = (int)L; { const int q = nwg / NXCD, r = nwg % NXCD, xcd = wgid % NXCD, off = wgid / NXCD; wgid = (xcd < r ? xcd * (q + 1) : r * (q + 1) + (xcd - r) * q) + off; }
        const int nig = wgm * nN, gid = wgid / nig, fm = gid * wgm, gsz = (nM - fm) < wgm ? (nM - fm) : wgm;
        u.pm = fm + ((wgid % nig) % gsz); u.pn = (wgid % nig) / gsz; u.e = 0; u.r0 = 0; u.nrows = BM; return true;
    }
    __device__ __forceinline__ const char* a_base(const Unit& u) const { return A + (size_t)u.pm * (size_t)BM * K * 2; }
    __device__ __forceinline__ const char* b_base(const Unit& u) const { return Bt + (size_t)u.pn * (size_t)BM * K * 2; }
    __device__ __forceinline__ void a_rows(const Unit&, int, LAS unsigned*) const {}
    __device__ __forceinline__ void wait_ready(const Unit&) const {}
};

struct MoeOrder {
    const char* A; const char* Bt; int K; size_t b_estride;
    const int* toklist; const volatile LAS int* tb; int ncol, G, c;
    int heavy;
    unsigned* ready; unsigned need;
    __device__ __forceinline__ void wait_ready(const Unit& u) const {
        if (ready) { unsigned* pc = ready + 16 * u.pm; unsigned sp = 0u; while (xb_ld(pc) < need) { __builtin_amdgcn_s_sleep(2); if (++sp > (1u << 20)) break; } }
    }
    __device__ bool next(int i, Unit& u) const {
        const int total = __builtin_amdgcn_readfirstlane(tb[32]) * ncol;
        int L0 = i * G + c;
        if (heavy > 0) { const int nl = G - heavy;
            L0 = (c >= heavy) ? (i == 0 ? c - heavy : nl + (i - 1) * G + c) : nl + i * G + c; }
        if (L0 >= total) return false;
        int L; { const int q = total / NXCD, r = total % NXCD, xcd = L0 % NXCD, off = L0 / NXCD; L = (xcd < r ? xcd * (q + 1) : r * (q + 1) + (xcd - r) * q) + off; }
        const int rt = L / ncol; u.pn = L - rt * ncol; u.pm = rt;
        int e = 0;
        for (int j = 1; j < 32; ++j) e = (tb[j] <= rt) ? j : e;
        u.e = e; u.r0 = (rt - tb[e]) * BM; const int left = tb[33 + e] - u.r0; u.nrows = left < BM ? left : BM;
        u.pm = __builtin_amdgcn_readfirstlane(u.pm); u.pn = __builtin_amdgcn_readfirstlane(u.pn); u.e = __builtin_amdgcn_readfirstlane(u.e); u.r0 = __builtin_amdgcn_readfirstlane(u.r0); u.nrows = __builtin_amdgcn_readfirstlane(u.nrows);
        return true;
    }
    __device__ __forceinline__ const char* a_base(const Unit& u) const { return toklist ? A : A + (size_t)u.pm * (size_t)BM * K * 2; }
    __device__ __forceinline__ const char* b_base(const Unit& u) const { return Bt + (size_t)u.e * b_estride + (size_t)u.pn * (size_t)BM * K * 2; }
    __device__ __forceinline__ void a_rows(const Unit& u, int tid, LAS unsigned* dst) const {
#pragma unroll
        for (int h = 0; h < 2; ++h)
#pragma unroll
            for (int i = 0; i < 2; ++i) { int R, C; stage_rc(tid * 16 + i * 8192, R, C); int r = h * HALF + R; r = r < u.nrows ? r : u.nrows - 1;
                const int tok = toklist[(size_t)u.e * MTOK + u.r0 + r]; dst[(h * 2 + i) * 512] = ((unsigned)tok * (unsigned)K + (unsigned)C) * 2u; }
    }
};

__device__ __forceinline__ void glds16(const char* sbase, unsigned voff, unsigned lds_dst) {
    unsigned keep;
    asm volatile("s_mov_b32 %0, m0\n\ts_mov_b32 m0, %3\n\ts_nop 0\n\tglobal_load_lds_dwordx4 %1, %2\n\ts_mov_b32 m0, %0" : "=&s"(keep) : "v"(voff), "s"(sbase), "s"(lds_dst) : "memory");
}
__device__ __forceinline__ const char* uniform_ptr(const char* p) { const unsigned long long v = (unsigned long long)p; const unsigned lo = __builtin_amdgcn_readfirstlane((unsigned)v), hi = __builtin_amdgcn_readfirstlane((unsigned)(v >> 32)); return (const char*)(((unsigned long long)hi << 32) | lo); }
template <class Epi, class Sched, bool GATHER, bool MIDK, bool FP8 = false>
__device__ __forceinline__ void gemm_phase(LAS unsigned char* lds, const Sched& S, const Epi& E, int wid) {
    int lane = hw_lane(); asm volatile("" : "+v"(lane));
    const int tid = wid * 64 + lane, wr = wid >> 2, wc = wid & 3, fr = lane & 15, fq = lane >> 4;
    const int K = S.K, nt = K / BK;
    unsigned voffA[2], voffB[2];
#pragma unroll
    for (int i = 0; i < 2; ++i) { int R, C; stage_rc(tid * 16 + i * 8192, R, C); const int Rb = Epi::PERM ? ((R & ~31) + perm32(R & 31)) : R;
        voffA[i] = (unsigned)(R * K + C) * 2u; voffB[i] = (unsigned)(Rb * K + C) * 2u; }
    const size_t kstep = (size_t)(BK * 2);
    const size_t hstep = (size_t)HALF * K * 2;
    const unsigned ldsw = (unsigned)wid * 1024u;
    const int aoff = lds_byte(wr * 64 + fr, fq * 8), boff = lds_byte(wc * 32 + fr, fq * 8);
    LAS unsigned* gofs = (LAS unsigned*)(lds + STAGE_BYTES) + tid;
    int par = 0;
#define PG8_SA(b, h) (((b) * 2 + (h)) * HTB)
#define PG8_SB(b, h) ((4 + (b) * 2 + (h)) * HTB)
    const unsigned ldsbase = (unsigned)(unsigned long long)lds + ldsw;
#define PG8_STAGE(bufoff, gbase, voff) do { const char* _gb = uniform_ptr((const char*)(gbase)); _Pragma("unroll") for (int _i = 0; _i < 2; ++_i) glds16(_gb, (voff)[_i], ldsbase + (bufoff) + _i * 8192); } while (0)
#define PG8_STAGE_A(bufoff, kbase, h, nx) do { if constexpr (GATHER) { const char* _gb = uniform_ptr((const char*)(kbase)); _Pragma("unroll") for (int _i = 0; _i < 2; ++_i) { const unsigned _o = gofs[((((nx) ? par ^ 1 : par) * 4) + (h) * 2 + _i) * 512]; \
        glds16(_gb, _o, ldsbase + (bufoff) + _i * 8192); } } \
        else { PG8_STAGE(bufoff, (const char*)(kbase) + ((h) ? hstep : (size_t)0), voffA); } } while (0)
    const LAS unsigned char* ldsA = lds + aoff; const LAS unsigned char* ldsB = lds + 4 * HTB + boff;
#define PG8_LD8(ptr, imm) __builtin_shufflevector(*(const LAS i32x4*)((ptr) + (imm)), *(const LAS i32x4*)((ptr) + (imm) + 1024), 0, 1, 2, 3, 4, 5, 6, 7)
#define PG8_LDA(dst, b, h) do { _Pragma("unroll") for (int m = 0; m < 4; ++m) dst[m] = PG8_LD8(ldsA, ((b) * 2 + (h)) * HTB + m * 2048); } while (0)
#define PG8_LDB(dst, b, h) do { _Pragma("unroll") for (int n = 0; n < 2; ++n) dst[n] = PG8_LD8(ldsB, ((b) * 2 + (h)) * HTB + n * 2048); } while (0)
#define PG8_LO(v) __builtin_bit_cast(bf16x8, __builtin_shufflevector(v, v, 0, 1, 2, 3))
#define PG8_HI(v) __builtin_bit_cast(bf16x8, __builtin_shufflevector(v, v, 4, 5, 6, 7))
#define PG8_MMA(ai, bj, At, Bt) do { __builtin_amdgcn_s_setprio(1); if constexpr (FP8) { _Pragma("unroll") for (int m = 0; m < 4; ++m) _Pragma("unroll") for (int n = 0; n < 2; ++n) \
        acc[ai][bj][m][n] = __builtin_amdgcn_mfma_scale_f32_16x16x128_f8f6f4(Bt[n], At[m], acc[ai][bj][m][n], 0, 0, 0, 0x7f7f7f7f, 0, 0x7f7f7f7f); } \
        else { _Pragma("unroll") for (int m = 0; m < 4; ++m) _Pragma("unroll") for (int n = 0; n < 2; ++n) { \
        acc[ai][bj][m][n] = __builtin_amdgcn_mfma_f32_16x16x32_bf16(PG8_LO(Bt[n]), PG8_LO(At[m]), acc[ai][bj][m][n], 0, 0, 0); \
        acc[ai][bj][m][n] = __builtin_amdgcn_mfma_f32_16x16x32_bf16(PG8_HI(Bt[n]), PG8_HI(At[m]), acc[ai][bj][m][n], 0, 0, 0); } } __builtin_amdgcn_s_setprio(0); } while (0)
#define PG8_WAIT_V(n) asm volatile("s_waitcnt vmcnt(" #n ")" ::: "memory")
#define PG8_WAIT_L(n) asm volatile("s_waitcnt lgkmcnt(" #n ")" ::: "memory")
#define PG8_BAR __builtin_amdgcn_s_barrier()
#define PG8_SCHED __builtin_amdgcn_sched_barrier(0)
    Unit cur, nxt; int ui = 0;
    if (!S.next(0, cur)) return;
    S.wait_ready(cur);
    f32x4 acc[2][2][4][2];
#pragma unroll
    for (int a = 0; a < 2; ++a)
#pragma unroll
        for (int b = 0; b < 2; ++b)
#pragma unroll
            for (int m = 0; m < 4; ++m)
#pragma unroll
                for (int n = 0; n < 2; ++n) acc[a][b][m][n] = (f32x4){0.f, 0.f, 0.f, 0.f};
    i32x8 At[4], B0[2], B1[2];
    const char* cA = S.a_base(cur); const char* cB = S.b_base(cur);
    if constexpr (GATHER) S.a_rows(cur, tid, gofs);
    PG8_STAGE(PG8_SB(0, 0), cB, voffB); PG8_STAGE(PG8_SB(0, 1), cB + hstep, voffB); PG8_STAGE_A(PG8_SA(0, 0), cA, 0, false); PG8_STAGE_A(PG8_SA(0, 1), cA, 1, false);
    if (wr == 1) PG8_BAR;
    PG8_WAIT_V(2); PG8_BAR;
    PG8_STAGE(PG8_SB(1, 0), cB + kstep, voffB); PG8_STAGE_A(PG8_SA(1, 0), cA + kstep, 0, false); PG8_STAGE(PG8_SB(1, 1), cB + hstep + kstep, voffB);
    PG8_WAIT_V(6); PG8_BAR;
    for (;;) {
        const bool has_next = S.next(ui + 1, nxt);
        if (has_next) S.wait_ready(nxt);
        const char* nA = has_next ? S.a_base(nxt) : cA; const char* nB = has_next ? S.b_base(nxt) : cB;
        if constexpr (GATHER) S.a_rows(has_next ? nxt : cur, tid, gofs + (par ^ 1) * 4 * 512);
        for (int tb0 = 0; tb0 < nt; tb0 += (MIDK ? nt / 2 : nt)) {
        if constexpr (MIDK) { if (tb0 != 0) E.mid(acc, cur, wr, wc, fr, fq); }
        const int tend = tb0 + (MIDK ? nt / 2 : nt);
        for (int t = tb0; t < tend; t += 2) {
            const bool last = (t == nt - 2);
            const char* a1 = cA + (size_t)(t + 1) * kstep;
            const char* a2 = last ? nA : cA + (size_t)(t + 2) * kstep; const char* b2 = last ? nB : cB + (size_t)(t + 2) * kstep;
            const char* a3 = a2 + kstep; const char* b3 = b2 + kstep;
            PG8_LDB(B0, 0, 0); PG8_LDB(B1, 0, 1); PG8_SCHED; PG8_LDA(At, 0, 0); PG8_STAGE_A(PG8_SA(1, 1), a1, 1, false);
            PG8_WAIT_V(8); PG8_WAIT_L(0); PG8_BAR; PG8_MMA(0, 0, At, B0); PG8_MMA(0, 1, At, B1); PG8_BAR; PG8_SCHED;
            PG8_LDA(At, 0, 1); PG8_STAGE(PG8_SB(0, 0), b2, voffB); PG8_STAGE(PG8_SB(0, 1), b2 + hstep, voffB); PG8_STAGE_A(PG8_SA(0, 0), a2, 0, last);
            PG8_WAIT_V(8); PG8_WAIT_L(0); PG8_BAR; PG8_MMA(1, 0, At, B0); PG8_MMA(1, 1, At, B1); PG8_BAR; PG8_SCHED;
            PG8_LDB(B0, 1, 0); PG8_LDB(B1, 1, 1); PG8_SCHED; PG8_LDA(At, 1, 0); PG8_STAGE_A(PG8_SA(0, 1), a2, 1, last);
            PG8_WAIT_V(8); PG8_WAIT_L(0); PG8_BAR; PG8_MMA(0, 0, At, B0); PG8_MMA(0, 1, At, B1); PG8_BAR; PG8_SCHED;
            PG8_LDA(At, 1, 1); PG8_STAGE(PG8_SB(1, 0), b3, voffB); PG8_STAGE(PG8_SB(1, 1), b3 + hstep, voffB); PG8_STAGE_A(PG8_SA(1, 0), a3, 0, last);
            PG8_WAIT_V(8); PG8_WAIT_L(0); PG8_BAR; PG8_MMA(1, 0, At, B0); PG8_MMA(1, 1, At, B1); PG8_BAR; PG8_SCHED;
        }
        }
        if (wr == 0) PG8_BAR;
        E(acc, cur, wr, wc, fr, fq);
        if (!has_next) break;
#pragma unroll
        for (int a = 0; a < 2; ++a)
#pragma unroll
            for (int b = 0; b < 2; ++b)
#pragma unroll
                for (int m = 0; m < 4; ++m)
#pragma unroll
                    for (int n = 0; n < 2; ++n) acc[a][b][m][n] = (f32x4){0.f, 0.f, 0.f, 0.f};
        cur = nxt; cA = nA; cB = nB; ++ui;
        if constexpr (GATHER) par ^= 1;
        if (wr == 1) PG8_BAR;
    }
    PG8_WAIT_V(0);
    PG8_BAR;
#undef PG8_SA
#undef PG8_SB
#undef PG8_STAGE
#undef PG8_STAGE_A
#undef PG8_LDA
#undef PG8_LDB
#undef PG8_MMA
#undef PG8_LD8
#undef PG8_LO
#undef PG8_HI
#undef PG8_WAIT_V
#undef PG8_WAIT_L
#undef PG8_BAR
#undef PG8_SCHED
}

struct EpiGateUp {
    static constexpr bool PERM = true;
    bf16* H; float sc; unsigned* ready;
    __device__ __forceinline__ void operator()(const f32x4 (&acc)[2][2][4][2], const Unit& u, int wr, int wc, int, int) const {
        const int hl = hw_lane(); int frq = hl & 15; asm volatile("" : "+v"(frq)); int fqq = hl >> 4; asm volatile("" : "+v"(fqq));
        const int row0 = u.pm * BM + wr * 64 + frq, col0 = u.pn * HALF + wc * 32 + 8 * fqq;
#pragma unroll
        for (int ai = 0; ai < 2; ++ai)
#pragma unroll
            for (int m = 0; m < 4; ++m) {
                unsigned char* rowp = (unsigned char*)H + (size_t)(row0 + ai * HALF + m * 16) * EFF + col0;
                const f32x4 g0 = acc[ai][0][m][0] * sc, g1 = acc[ai][0][m][1] * sc, u0 = acc[ai][1][m][0] * (8.f * sc), u1 = acc[ai][1][m][1] * (8.f * sc);
#define EGU_C(x) fminf(fmaxf((x), -440.f), 440.f)
                u32x2 w;
                w.x = pk_fp8x4(EGU_C(siluf_(g0[0]) * u0[0]), EGU_C(siluf_(g0[1]) * u0[1]), EGU_C(siluf_(g0[2]) * u0[2]), EGU_C(siluf_(g0[3]) * u0[3]));
                w.y = pk_fp8x4(EGU_C(siluf_(g1[0]) * u1[0]), EGU_C(siluf_(g1[1]) * u1[1]), EGU_C(siluf_(g1[2]) * u1[2]), EGU_C(siluf_(g1[3]) * u1[3]));
#undef EGU_C
                asm volatile("global_store_dwordx2 %0, %1, off sc1\n\ts_nop 1" :: "v"(rowp), "v"(w) : "memory");
            }
        asm volatile("s_waitcnt vmcnt(0)" ::: "memory");
        if (hw_lane() == 0) (void)xb_add(ready + 16 * u.pm, 1u);
    }
};
struct EpiBf16 {
    static constexpr bool PERM = true;
    unsigned char* O; int ldc; float sc;
    __device__ __forceinline__ void operator()(const f32x4 (&acc)[2][2][4][2], const Unit& u, int wr, int wc, int fr, int fq) const {
        int frq = fr; asm volatile("" : "+v"(frq)); int fqq = fq; asm volatile("" : "+v"(fqq));
        const int row0 = u.pm * BM + wr * 64 + frq, col0 = u.pn * BM + wc * 32 + 8 * fqq;
#define EY_C(x) fminf(fmaxf((x) * sc, -440.f), 440.f)
#pragma unroll
        for (int ai = 0; ai < 2; ++ai)
#pragma unroll
            for (int m = 0; m < 4; ++m) {
                unsigned char* rowp = O + (size_t)(row0 + ai * HALF + m * 16) * ldc + col0;
#pragma unroll
                for (int bj = 0; bj < 2; ++bj) { const f32x4 v0 = acc[ai][bj][m][0], v1 = acc[ai][bj][m][1];
                    u32x2 w; w.x = pk_fp8x4(EY_C(v0[0]), EY_C(v0[1]), EY_C(v0[2]), EY_C(v0[3])); w.y = pk_fp8x4(EY_C(v1[0]), EY_C(v1[1]), EY_C(v1[2]), EY_C(v1[3]));
                    *(u32x2*)(rowp + bj * HALF) = w; }
            }
#undef EY_C
    }
};

struct EpiHcat {
    static constexpr bool PERM = true;
    bf16* O; float sc;
    __device__ __forceinline__ void operator()(const f32x4 (&acc)[2][2][4][2], const Unit& u, int wr, int wc, int, int) const {
        const int hl = hw_lane(); int frq = hl & 15; asm volatile("" : "+v"(frq)); int fqq = hl >> 4; asm volatile("" : "+v"(fqq));
        const int row0 = u.pm * BM + wr * 64 + frq;
        const int kind = u.pn < 4 ? 0 : (u.pn < 18 ? 1 : (u.pn < 22 ? 2 : 3));
        if (kind == 3) {
            const int c0 = 128 * (u.pn - 22) + wc * 32 + 8 * fqq;
#pragma unroll
            for (int ai = 0; ai < 2; ++ai)
#pragma unroll
                for (int m = 0; m < 4; ++m) {
                    bf16* rowp = O + (size_t)(row0 + ai * HALF + m * 16) * HC_W + 5632 + c0;
                    float rho[8], sb[8];
#pragma unroll
                    for (int n = 0; n < 2; ++n)
#pragma unroll
                        for (int j = 0; j < 4; ++j) { const float pa = 1.f + __expf(fminf(-acc[ai][0][m][n][j] * sc, 40.f)), pb = 1.f + __expf(fminf(-acc[ai][1][m][n][j] * sc, 40.f));
                            const float r = __builtin_amdgcn_rcpf(pa * pb);
                            sb[4 * n + j] = r * pa; rho[4 * n + j] = (pb * pb) * r; }
                    u32x4 w; w.x = pk2(rho[0], rho[1]); w.y = pk2(rho[2], rho[3]); w.z = pk2(rho[4], rho[5]); w.w = pk2(rho[6], rho[7]);
                    *(u32x4*)rowp = w;
                    w.x = pk2(sb[0], sb[1]); w.y = pk2(sb[2], sb[3]); w.z = pk2(sb[4], sb[5]); w.w = pk2(sb[6], sb[7]);
                    *(u32x4*)(rowp + 2048) = w;
                }
            return;
        }
        const int col0 = u.pn * BM + wc * 32 + 8 * fqq;
#pragma unroll
        for (int ai = 0; ai < 2; ++ai)
#pragma unroll
            for (int m = 0; m < 4; ++m) {
                bf16* rowp = O + (size_t)(row0 + ai * HALF + m * 16) * HC_W + col0;
#pragma unroll
                for (int bj = 0; bj < 2; ++bj) { f32x4 v0 = acc[ai][bj][m][0] * sc, v1 = acc[ai][bj][m][1] * sc;
                    if (kind == 0) { v0 = v0 * 0.125f; v1 = v1 * 0.125f; }
                    else if (kind == 2) {
#pragma unroll
                        for (int j = 0; j < 4; ++j) { v0[j] = siluf_(v0[j]); v1[j] = siluf_(v1[j]); } }
                    u32x4 w; w.x = pk2(v0[0], v0[1]); w.y = pk2(v0[2], v0[3]); w.z = pk2(v1[0], v1[1]); w.w = pk2(v1[2], v1[3]);
                    *(u32x4*)(rowp + bj * HALF) = w; }
            }
    }
};
struct EpiMerged {
    static constexpr bool PERM = true;
    const bf16* HC; bf16* O;
    __device__ __forceinline__ void mid(f32x4 (&acc)[2][2][4][2], const Unit& u, int wr, int wc, int fr, int fq) const {
        int frq = fr; asm volatile("" : "+v"(frq)); int fqq = fq; asm volatile("" : "+v"(fqq));
        const int row0 = u.pm * BM + wr * 64 + frq, col0 = u.pn * BM + wc * 32 + 8 * fqq;
#pragma unroll
        for (int ai = 0; ai < 2; ++ai) {
            u32x4 rh[4][2];
#pragma unroll
            for (int m = 0; m < 4; ++m)
#pragma unroll
                for (int bj = 0; bj < 2; ++bj) rh[m][bj] = *(const u32x4*)(HC + (size_t)(row0 + ai * HALF + m * 16) * HC_W + col0 + bj * HALF + 5632);
#pragma unroll
            for (int m = 0; m < 4; ++m)
#pragma unroll
                for (int bj = 0; bj < 2; ++bj) { const u32x4 a4 = rh[m][bj];
                    const f32x4 r0 = {bflo(a4.x), bfhi(a4.x), bflo(a4.y), bfhi(a4.y)}, r1 = {bflo(a4.z), bfhi(a4.z), bflo(a4.w), bfhi(a4.w)};
                    acc[ai][bj][m][0] = acc[ai][bj][m][0] * r0; acc[ai][bj][m][1] = acc[ai][bj][m][1] * r1; }
            asm volatile("" : "+v"(acc[ai][0][0][0]), "+v"(acc[ai][1][3][1]) :: "memory");
        }
    }
    __device__ __forceinline__ void operator()(const f32x4 (&acc)[2][2][4][2], const Unit& u, int wr, int wc, int fr, int fq) const {
        int frq = fr; asm volatile("" : "+v"(frq)); int fqq = fq; asm volatile("" : "+v"(fqq));
        const int row0 = u.pm * BM + wr * 64 + frq, col0 = u.pn * BM + wc * 32 + 8 * fqq;
#pragma unroll
        for (int ai = 0; ai < 2; ++ai) {
            u32x4 sb[4][2];
#pragma unroll
            for (int m = 0; m < 4; ++m)
#pragma unroll
                for (int bj = 0; bj < 2; ++bj) sb[m][bj] = *(const u32x4*)(HC + (size_t)(row0 + ai * HALF + m * 16) * HC_W + col0 + 7680 + bj * HALF);
#pragma unroll
            for (int m = 0; m < 4; ++m)
#pragma unroll
                for (int bj = 0; bj < 2; ++bj) { const u32x4 b4 = sb[m][bj];
                    const f32x4 v0 = acc[ai][bj][m][0], v1 = acc[ai][bj][m][1];
                    u32x2 w;
                    w.x = pk_fp8x4(0.125f * v0[0] * fmaxf(bflo(b4.x), 1e-20f), 0.125f * v0[1] * fmaxf(bfhi(b4.x), 1e-20f), 0.125f * v0[2] * fmaxf(bflo(b4.y), 1e-20f), 0.125f * v0[3] * fmaxf(bfhi(b4.y), 1e-20f));
                    w.y = pk_fp8x4(0.125f * v1[0] * fmaxf(bflo(b4.z), 1e-20f), 0.125f * v1[1] * fmaxf(bfhi(b4.z), 1e-20f), 0.125f * v1[2] * fmaxf(bflo(b4.w), 1e-20f), 0.125f * v1[3] * fmaxf(bfhi(b4.w), 1e-20f));
                    *(u32x2*)((unsigned char*)O + (size_t)(row0 + ai * HALF + m * 16) * D + col0 + bj * HALF) = w; }
            asm volatile("" ::: "memory");
        }
    }
};
struct EpiMixG {
    static constexpr bool PERM = true;
    const float* MODv; bf16* O; float sc;
    __device__ __forceinline__ void operator()(const f32x4 (&acc)[2][2][4][2], const Unit& u, int wr, int wc, int fr, int fq) const {
        int frq = fr; asm volatile("" : "+v"(frq)); int fqq = fq; asm volatile("" : "+v"(fqq));
        const int row0 = u.pm * BM + wr * 64 + frq, col0 = u.pn * BM + wc * 32 + 8 * fqq;
        const float* g1 = MODv + (size_t)((u.pm * BM) / SEQ) * 6 * D + 2 * D;
        f32x4 gv[2][2];
#pragma unroll
        for (int bj = 0; bj < 2; ++bj)
#pragma unroll
            for (int n = 0; n < 2; ++n) gv[bj][n] = *(const f32x4*)(g1 + col0 + bj * HALF + 4 * n) * sc;
#pragma unroll
        for (int ai = 0; ai < 2; ++ai)
#pragma unroll
            for (int m = 0; m < 4; ++m) {
                bf16* rowp = O + (size_t)(row0 + ai * HALF + m * 16) * D + col0;
#pragma unroll
                for (int bj = 0; bj < 2; ++bj) { const f32x4 v0 = acc[ai][bj][m][0] * gv[bj][0], v1 = acc[ai][bj][m][1] * gv[bj][1];
                    u32x4 w; w.x = pk2(v0[0], v0[1]); w.y = pk2(v0[2], v0[3]); w.z = pk2(v1[0], v1[1]); w.w = pk2(v1[2], v1[3]);
                    *(u32x4*)(rowp + bj * HALF) = w; }
            }
    }
};
}

__device__ __forceinline__ float shx(float v, int o, int lane) { return __int_as_float(__builtin_amdgcn_ds_bpermute((lane ^ o) << 2, __float_as_int(v))); }
__device__ __forceinline__ float shl_(float v, int src_lane) { return __int_as_float(__builtin_amdgcn_ds_bpermute(src_lane << 2, __float_as_int(v))); }
__device__ __forceinline__ float wave_sum(float v, int lane) {
#pragma unroll
    for (int o = 1; o < 64; o <<= 1) v += shx(v, o, lane);
    return v;
}

struct Args { const float* in[23]; float* out; unsigned char* ws; };
enum { I_X = 0, I_C, I_WADA, I_BADA, I_WIN, I_CONVW, I_SINKS, I_ALOG, I_DTB, I_NORMW, I_WPA, I_WPB, I_WOUT, I_LN1G, I_LN1B, I_WRG, I_BRG, I_WRE, I_BRE, I_WGU, I_WDN, I_LN2G, I_LN2B };

__device__ __forceinline__ void ln_norm(f32x4 (&v)[8], int lane) {
    float s = 0.f;
#pragma unroll
    for (int j = 0; j < 8; ++j) s += (v[j].x + v[j].y) + (v[j].z + v[j].w);
    const float mean = wave_sum(s, lane) * (1.f / D);
    float s2 = 0.f;
#pragma unroll
    for (int j = 0; j < 8; ++j) { v[j] = v[j] - mean; s2 += (v[j].x * v[j].x + v[j].y * v[j].y) + (v[j].z * v[j].z + v[j].w * v[j].w); }
    const float rstd = 1.f / sqrtf(wave_sum(s2, lane) * (1.f / D) + LN_EPS);
#pragma unroll
    for (int j = 0; j < 8; ++j) v[j] = v[j] * rstd;
}

struct TDesc { const float* src; bf16* dst; int ldsrc, lddst; float f8scale; };
__device__ __forceinline__ void t_load(const TDesc& d, int lane, f32x4 (&v)[8]) {
#pragma unroll
    for (int i = 0; i < 8; ++i) v[i] = __builtin_nontemporal_load((const f32x4*)(d.src + (size_t)(8 * i + (lane >> 3)) * d.ldsrc + 4 * (lane & 7)));
}
__device__ __forceinline__ void t_store(const TDesc& d, const f32x4 (&v)[8], LAS float* scr, int lane) {
#pragma unroll
    for (int i = 0; i < 8; ++i) { LAS float* q = scr + (8 * i + (lane >> 3)) * 33 + 4 * (lane & 7); q[0] = v[i][0]; q[1] = v[i][1]; q[2] = v[i][2]; q[3] = v[i][3]; }
    LDS_WAIT(); asm volatile("" ::: "memory");
    const int c = lane & 7;
#pragma unroll
    for (int j = 0; j < 4; ++j) { const int n = (lane >> 3) + 8 * j; const LAS float* sp = scr + (8 * c) * 33 + n;
        if (d.f8scale != 0.f) { const float f = d.f8scale; u32x2 o8; o8.x = pk_fp8x4(sp[0 * 33] * f, sp[1 * 33] * f, sp[2 * 33] * f, sp[3 * 33] * f); o8.y = pk_fp8x4(sp[4 * 33] * f, sp[5 * 33] * f, sp[6 * 33] * f, sp[7 * 33] * f);
            __builtin_nontemporal_store(o8, (u32x2*)((unsigned char*)d.dst + (size_t)n * d.lddst + 8 * c)); }
        else { u32x4 o; o.x = pk2(sp[0 * 33], sp[1 * 33]); o.y = pk2(sp[2 * 33], sp[3 * 33]); o.z = pk2(sp[4 * 33], sp[5 * 33]); o.w = pk2(sp[6 * 33], sp[7 * 33]);
            __builtin_nontemporal_store(o, (u32x4*)(d.dst + (size_t)n * d.lddst + 8 * c)); } }
    LDS_WAIT(); asm volatile("" ::: "memory");
}
constexpr int TI_IN = 32 * 304, TI_PA = 16 * 64, TI_PB = 16 * 64, TI_OUT = 32 * 64, TI_P0 = TI_IN + TI_PA + TI_PB + TI_OUT;
__device__ __forceinline__ TDesc p0_desc(int r, const float* win, const float* wpa, const float* wpb, const float* wout, bf16* WIN, bf16* WP, bf16* WOUT) {
    TDesc d; d.f8scale = 0.f;
    if (r < TI_IN) { const int kb = r / 304, nb = r - kb * 304, nd = 32 * nb; int ns = nd;
        if (nd >= 5632) { const int g = nd - 5632, t = g >> 8, j = g & 255; ns = (j < 128 ? 5648 : 7696 - 128) + 128 * t + j; }
        d.src = win + (size_t)(64 * kb) * IN_W + ns; d.ldsrc = IN_W; d.dst = (bf16*)((unsigned char*)WIN + (size_t)nd * D + 64 * kb); d.lddst = D; d.f8scale = 64.f; return d; }
    r -= TI_IN;
    if (r < TI_PA) { const int kb = r >> 6, nb = r & 63; d.src = wpa + (size_t)(64 * kb) * D + 32 * nb; d.ldsrc = D; d.dst = (bf16*)((unsigned char*)WP + (size_t)(32 * nb) * D + 64 * kb); d.lddst = D; d.f8scale = 64.f; return d; }
    r -= TI_PA;
    if (r < TI_PB) { const int kb = r >> 6, nb = r & 63; d.src = wpb + (size_t)(64 * kb) * D + 32 * nb; d.ldsrc = D; d.dst = (bf16*)((unsigned char*)WP + (size_t)(32 * nb) * D + 1024 + 64 * kb); d.lddst = D; d.f8scale = 64.f; return d; }
    r -= TI_PB;
    { const int kb = r >> 6, nb = r & 63; d.src = wout + (size_t)(64 * kb) * D + 32 * nb; d.ldsrc = D; d.dst = (bf16*)((unsigned char*)WOUT + (size_t)(32 * nb) * D + 64 * kb); d.lddst = D; d.f8scale = 64.f; return d; }
}
constexpr int TI_GU = 32 * 32 * 32, TI_DN = 32 * 8 * 64, TI_MOE = TI_GU + TI_DN;
constexpr int TI_EARLY = 3072;
__device__ __forceinline__ TDesc moe_desc(int r, const float* wgu, const float* wdn, bf16* WGU, bf16* WD) {
    TDesc d; d.f8scale = 0.f;
    if (r < TI_GU) { const int e = r >> 10, rr = r & 1023, kb = rr >> 5, nb = rr & 31, nd = 32 * nb, pn = nd >> 8, j0 = nd & 255;
        const int ns = j0 < 128 ? 128 * pn + j0 : 512 + 128 * pn + (j0 - 128);
        d.src = wgu + (size_t)e * D * 1024 + (size_t)(64 * kb) * 1024 + ns; d.ldsrc = 1024; d.dst = (bf16*)((unsigned char*)WGU + (size_t)e * 1024 * D + (size_t)nd * D + 64 * kb); d.lddst = D; d.f8scale = 64.f; return d; }
    r -= TI_GU;
    { const int e = r >> 9, rr = r & 511, kb = rr >> 6, nb = rr & 63;
        d.src = wdn + (size_t)e * EFF * D + (size_t)(64 * kb) * D + 32 * nb; d.ldsrc = D; d.dst = (bf16*)((unsigned char*)WD + (size_t)e * D * EFF + (size_t)(32 * nb) * EFF + 64 * kb); d.lddst = EFF; d.f8scale = 64.f; return d; }
}

constexpr int MOD_KS = 16;
__device__ __forceinline__ void p0_mod_item(const float* cvec, const float* wada, float* modp, int item, int lane) {
    const int cchunk = item % 192, ks = item / 192, c0 = 64 * cchunk, cg = lane & 15, rg = lane >> 4;
    f32x4 acc[4];
#pragma unroll
    for (int b = 0; b < 4; ++b) acc[b] = (f32x4){0.f, 0.f, 0.f, 0.f};
    const float* wp = wada + (size_t)(128 * ks + rg) * (6 * D) + c0 + 4 * cg;
    const float* cp = cvec + 128 * ks + rg;
#pragma unroll 8
    for (int i = 0; i < 32; ++i) {
        const f32x4 w = __builtin_nontemporal_load((const f32x4*)(wp + (size_t)(4 * i) * (6 * D)));
#pragma unroll
        for (int b = 0; b < 4; ++b) { const float sv = siluf_(cp[b * D + 4 * i]); acc[b] = acc[b] + w * sv; }
    }
#pragma unroll
    for (int b = 0; b < 4; ++b)
#pragma unroll
        for (int j = 0; j < 4; ++j) { float v = acc[b][j]; v += shx(v, 16, lane); v += shx(v, 32, lane); acc[b][j] = v; }
    if (rg == 0) {
#pragma unroll
        for (int b = 0; b < 4; ++b) *(f32x4*)(modp + ((size_t)ks * 4 + b) * (6 * D) + c0 + 4 * cg) = acc[b];
    }
}
__device__ __forceinline__ float mod_sum(const float* modp, size_t o) { float v = 0.f;
#pragma unroll
    for (int ks = 0; ks < MOD_KS; ++ks) v += modp[o + (size_t)ks * 4 * 6 * D];
    return v; }

__device__ __forceinline__ f32x16 zero16() { f32x16 z;
#pragma unroll
    for (int i = 0; i < 16; ++i) z[i] = 0.f;
    return z; }

constexpr int ATT_KS_STRIDE = 144;
constexpr int ATT_VT_STRIDE = 196;
constexpr int ATT_VT_OFF = 192 * ATT_KS_STRIDE;
__device__ __forceinline__ void swa_unit(LAS unsigned char* lds, const bf16* HC, bf16* OAOB, const float* sinks, int unit, int tid, int lane, int wave) {
    const int kvh = unit & 3, n = (unit >> 2) & 63, b = unit >> 8;
    const int nkc = n < 2 ? n + 1 : 3;
    const int key0 = (n + 1 - nkc) * 64;
    const size_t tokb = (size_t)b * SEQ;
    LAS unsigned char* Ks = lds;
    LAS unsigned short* Vt = (LAS unsigned short*)(lds + ATT_VT_OFF);
    __syncthreads();
    const int nkeys = nkc * 64;
    for (int p = tid; p < nkeys * 8; p += NTHREADS) {
        const int key = p >> 3, dc = p & 7;
        const bf16* src = HC + (tokb + key0 + key) * HC_W;
        const u32x4 kv = *(const u32x4*)(src + 1024 + kvh * 64 + dc * 8);
        const u32x4 vv = *(const u32x4*)(src + 1280 + kvh * 64 + dc * 8);
        *(LAS u32x4*)(Ks + key * ATT_KS_STRIDE + dc * 16) = kv;
        LAS unsigned short* vt = Vt + (dc * 8) * ATT_VT_STRIDE + key;
        vt[0 * ATT_VT_STRIDE] = (unsigned short)(vv.x & 0xffffu); vt[1 * ATT_VT_STRIDE] = (unsigned short)(vv.x >> 16);
        vt[2 * ATT_VT_STRIDE] = (unsigned short)(vv.y & 0xffffu); vt[3 * ATT_VT_STRIDE] = (unsigned short)(vv.y >> 16);
        vt[4 * ATT_VT_STRIDE] = (unsigned short)(vv.z & 0xffffu); vt[5 * ATT_VT_STRIDE] = (unsigned short)(vv.z >> 16);
        vt[6 * ATT_VT_STRIDE] = (unsigned short)(vv.w & 0xffffu); vt[7 * ATT_VT_STRIDE] = (unsigned short)(vv.w >> 16);
    }
    __syncthreads();
    const int g = wave >> 1, th = wave & 1, r31 = lane & 31, h = lane >> 5;
    const int head = kvh * 4 + g;
    const size_t qtok = tokb + (size_t)n * 64 + th * 32 + r31;
    bf16x8 qf[4];
#pragma unroll
    for (int ks = 0; ks < 4; ++ks) qf[ks] = *(const bf16x8*)(HC + qtok * HC_W + head * 64 + ks * 16 + 8 * h);
    const int nkt = 2 * nkc;
    f32x16 s[6];
#pragma unroll
    for (int kt = 0; kt < 6; ++kt) {
        s[kt] = zero16();
        if (kt < nkt) {
#pragma unroll
            for (int ks = 0; ks < 4; ++ks) {
                const bf16x8 A = *(const LAS bf16x8*)(Ks + (kt * 32 + r31) * ATT_KS_STRIDE + (ks * 16 + 8 * h) * 2);
                s[kt] = __builtin_amdgcn_mfma_f32_32x32x16_bf16(A, qf[ks], s[kt], 0, 0, 0);
            }
        }
    }
    const float sink = sinks[head];
    float mx = sink;
#pragma unroll
    for (int kt = 0; kt < 6; ++kt) if (kt < nkt) {
#pragma unroll
        for (int i = 0; i < 16; ++i) mx = fmaxf(mx, s[kt][i]); }
    mx = fmaxf(mx, shx(mx, 32, lane));
    float sum = 0.f;
#pragma unroll
    for (int kt = 0; kt < 6; ++kt) if (kt < nkt) {
#pragma unroll
        for (int i = 0; i < 16; ++i) { const float pv = __expf(s[kt][i] - mx); s[kt][i] = pv; sum += pv; } }
    sum += shx(sum, 32, lane);
    sum += __expf(sink - mx);
    const float inv = 1.f / sum;
    f32x16 o[2]; o[0] = zero16(); o[1] = zero16();
#pragma unroll
    for (int kt = 0; kt < 6; ++kt) if (kt < nkt) {
#pragma unroll
        for (int st = 0; st < 2; ++st) {
            u32x4 pb; pb.x = pk2(s[kt][8 * st + 0], s[kt][8 * st + 1]); pb.y = pk2(s[kt][8 * st + 2], s[kt][8 * st + 3]); pb.z = pk2(s[kt][8 * st + 4], s[kt][8 * st + 5]); pb.w = pk2(s[kt][8 * st + 6], s[kt][8 * st + 7]);
            const bf16x8 B = __builtin_bit_cast(bf16x8, pb);
#pragma unroll
            for (int mt = 0; mt < 2; ++mt) {
                const LAS unsigned short* vp = Vt + (32 * mt + r31) * ATT_VT_STRIDE + kt * 32 + 16 * st + 4 * h;
                const u32x2 a0 = *(const LAS u32x2*)vp, a1 = *(const LAS u32x2*)(vp + 8);
                u32x4 av; av.x = a0.x; av.y = a0.y; av.z = a1.x; av.w = a1.y;
                o[mt] = __builtin_amdgcn_mfma_f32_32x32x16_bf16(__builtin_bit_cast(bf16x8, av), B, o[mt], 0, 0, 0);
            }
        }
    }
    unsigned char* orow = (unsigned char*)OAOB + qtok * D + head * 64;
    const float inv4 = 4.f * inv;
#pragma unroll
    for (int mt = 0; mt < 2; ++mt)
#pragma unroll
        for (int rg = 0; rg < 4; ++rg)
            *(unsigned*)(orow + 32 * mt + 8 * rg + 4 * h) = pk_fp8x4(o[mt][4 * rg + 0] * inv4, o[mt][4 * rg + 1] * inv4, o[mt][4 * rg + 2] * inv4, o[mt][4 * rg + 3] * inv4);
}

constexpr int GU_NW = 0, GU_UT = 16384, GU_QD = 32768, GU_KDT = 49152, GU_QK = 65536, GU_BYTES = 73728;
constexpr int GP_Y = 67584, GP_SM = 67584 + 73728;
#define GP_ROW(t) ((t) * 272 + 16 * ((t) >> 3))
constexpr int GP_QN = 17520, GP_KE = 35040, GP_VB = 52560;
__host__ __device__ __forceinline__ constexpr int tri_off(int i) { const int a = i >> 2, r = i & 3; return 8 * a * a + 4 * a + (r >= 1 ? 4 * a : 0) + (r >= 2 ? 4 * a + 4 : 0) + (r == 3 ? 4 * a + 4 : 0); }

__host__ __device__ __forceinline__ constexpr int kperm4(int k) { return (k & ~31) + 8 * ((k >> 2) & 3) + 4 * ((k >> 4) & 1) + (k & 3); }
__device__ __forceinline__ void conv8(const u32x4 (&rows)[5], const LAS float* cw, float (&y)[2][8]) {
    float xr[5][8];
#pragma unroll
    for (int r = 0; r < 5; ++r) { const u32x4 w = rows[r];
        xr[r][0] = bflo(w.x); xr[r][1] = bfhi(w.x); xr[r][2] = bflo(w.y); xr[r][3] = bfhi(w.y); xr[r][4] = bflo(w.z); xr[r][5] = bfhi(w.z); xr[r][6] = bflo(w.w); xr[r][7] = bfhi(w.w); }
    float wv[4][8];
#pragma unroll
    for (int i = 0; i < 4; ++i) { const f32x4 a = *(const LAS f32x4*)(cw + i * 128), b = *(const LAS f32x4*)(cw + i * 128 + 4);
        wv[i][0] = a[0]; wv[i][1] = a[1]; wv[i][2] = a[2]; wv[i][3] = a[3]; wv[i][4] = b[0]; wv[i][5] = b[1]; wv[i][6] = b[2]; wv[i][7] = b[3]; }
#pragma unroll
    for (int d = 0; d < 8; ++d) {
        const float y0 = ((xr[0][d] * wv[0][d] + xr[1][d] * wv[1][d]) + xr[2][d] * wv[2][d]) + xr[3][d] * wv[3][d];
        const float y1 = ((xr[1][d] * wv[0][d] + xr[2][d] * wv[1][d]) + xr[3][d] * wv[2][d]) + xr[4][d] * wv[3][d];
        y[0][d] = siluf_(y0); y[1][d] = siluf_(y1);
    }
}
__device__ __forceinline__ float red16(float v, int lane) { v += shx(v, 1, lane); v += shx(v, 2, lane); v += shx(v, 4, lane); v += shx(v, 8, lane); return v; }
__device__ __forceinline__ u32x4 pack8(const float (&v)[8]) { u32x4 w; w.x = pk2(v[0], v[1]); w.y = pk2(v[2], v[3]); w.z = pk2(v[4], v[5]); w.w = pk2(v[6], v[7]); return w; }
__device__ __forceinline__ u32x2 pack4(const f32x4 v) { u32x2 w; w.x = pk2(v[0], v[1]); w.y = pk2(v[2], v[3]); return w; }

__device__ __forceinline__ void gdn_pre(LAS unsigned char* lds, const bf16* HC, const float* convw, const float* BETA, const float* GG, unsigned char* GDN, unsigned char* SCR, float* DECS, int ug, int tid, int lane, int wave) {
    asm volatile("" : "+v"(tid), "+v"(lane));
    LAS float* AM = (LAS float*)lds;
    LAS unsigned char* YR = lds + GP_Y;
    LAS float* SM = (LAS float*)(lds + GP_SM);
    const int fr = lane & 15, fq = lane >> 4;
    LAS float* CW = (LAS float*)(lds + GP_SM + 1024);
    {
        const int h0 = ((ug * 8) >> 6) & 7;
        for (int i = tid; i < 1536; i += NTHREADS) { const int ts = i >> 9, tap = (i >> 7) & 3, d = i & 127; CW[i] = convw[(size_t)tap * 3072 + ts * 1024 + h0 * 128 + d]; }
    }
    u32x4 nr[3][5]; float nbt = 0.f, ngv = 0.f;
#define GP_LOADROWS(u_) do { const int _c = (u_) & 63, _h = ((u_) >> 6) & 7, _b = (u_) >> 9; int _dg = tid & 15, _tq = tid >> 4; asm volatile("" : "+v"(_dg), "+v"(_tq));     \
        const int _t0 = 2 * _tq; const bf16* _base = HC + ((size_t)_b * SEQ + (size_t)_c * 64) * HC_W + _h * 128 + 1536 + 8 * _dg; const bool _z = (_c == 0); \
        _Pragma("unroll") for (int ts = 0; ts < 3; ++ts) _Pragma("unroll") for (int r = 0; r < 5; ++r) { const bool _zz = _z && (_t0 - 3 + r < 0); \
            const u32x4 _w = *(const u32x4*)(_base + (ptrdiff_t)(_zz ? 0 : (_t0 - 3 + r)) * HC_W + ts * 1024); \
            nr[ts][r] = _zz ? (u32x4){0u, 0u, 0u, 0u} : _w; } \
        if (wave == 0) { const size_t _tk = (size_t)_b * SEQ + (size_t)_c * 64 + lane; ngv = GG[_tk * 8 + _h]; nbt = BETA[_tk * 8 + _h]; } } while (0)
    GP_LOADROWS(ug * 8);
    const int lane_outer = lane;
#pragma unroll 1
    for (int uu = 0; uu < 8; ++uu) {
        int lane_it = lane_outer; asm volatile("" : "+v"(lane_it));
        const int lane = lane_it, tid = wave * 64 + lane_it;
        const int u = ug * 8 + uu;
        unsigned char* gb = GDN + (size_t)u * GU_BYTES;
        unsigned char* sb = SCR + (size_t)u * 32768;
        const float gv = ngv, btw = nbt;
        __syncthreads();
        if (wave == 0) {
            float xs = gv;
#pragma unroll
            for (int off = 1; off < 64; off <<= 1) { const float yv = shl_(xs, lane >= off ? lane - off : lane); if (lane >= off) xs += yv; }
            const float last = shl_(xs, 63);
            SM[lane] = xs; SM[64 + lane] = btw; SM[128 + lane] = __expf(xs); SM[192 + lane] = __expf(last - xs);
            if (lane == 0) DECS[u] = __expf(last);
        }
        __syncthreads();
        {
            int dg = tid & 15, tq = tid >> 4; asm volatile("" : "+v"(dg), "+v"(tq));
            const int t0 = 2 * tq;
            float qv[2][8], kv[2][8], vv[2][8];
            conv8(nr[0], CW + 8 * dg, qv);
            conv8(nr[1], CW + 512 + 8 * dg, kv);
            conv8(nr[2], CW + 1024 + 8 * dg, vv);
            asm volatile("" ::: "memory");
            { const int un = uu + 1 < 8 ? u + 1 : u; GP_LOADROWS(un); }
            float bt[2], ec[2], ek[2];
#pragma unroll
            for (int r = 0; r < 2; ++r) { bt[r] = SM[64 + t0 + r]; ec[r] = SM[128 + t0 + r]; ek[r] = SM[192 + t0 + r]; }
#pragma unroll
            for (int r = 0; r < 2; ++r) {
                float sq = 0.f, sk = 0.f;
#pragma unroll
                for (int d = 0; d < 8; ++d) { sq += qv[r][d] * qv[r][d]; sk += kv[r][d] * kv[r][d]; }
                sq = red16(sq, lane); sk = red16(sk, lane);
                const float rq = rsqrtf(sq + 1e-6f) * 0.08838834764831845f, rk = rsqrtf(sk + 1e-6f);
                float qd[8];
#pragma unroll
                for (int d = 0; d < 8; ++d) { qv[r][d] *= rq; kv[r][d] *= rk; qd[d] = qv[r][d] * ec[r]; }
                const int ro = GP_ROW(t0 + r) + 16 * dg;
                *(LAS u32x4*)(YR + ro) = pack8(kv[r]);
                *(LAS u32x4*)(YR + GP_QN + ro) = pack8(qv[r]);
                { float ke[8], vb[8];
#pragma unroll
                  for (int d = 0; d < 8; ++d) { ke[d] = kv[r][d] * ek[r]; vb[d] = vv[r][d] * bt[r]; }
                  *(LAS u32x4*)(YR + GP_KE + ro) = pack8(ke); *(LAS u32x4*)(YR + GP_VB + ro) = pack8(vb); }
                { const u32x4 w8 = pack8(qd); *(u32x2*)(gb + GU_QD + ((t0 + r) * 128 + kperm4(8 * dg)) * 2) = (u32x2){w8.x, w8.y}; *(u32x2*)(gb + GU_QD + ((t0 + r) * 128 + kperm4(8 * dg + 4)) * 2) = (u32x2){w8.z, w8.w}; }
            }
        }
        __syncthreads();
        {
#pragma unroll
            for (int q = 0; q < 2; ++q) {
                int pp = tid + q * NTHREADS; asm volatile("" : "+v"(pp));
                const int d = pp >> 3, j = pp & 7;
                const LAS unsigned char* colp = YR + 2 * d;
                unsigned hv[8];
#pragma unroll
                for (int k = 0; k < 8; ++k) hv[k] = *(const LAS unsigned short*)(colp + GP_VB + GP_ROW(8 * j + k));
                { u32x4 w; w.x = hv[0] | (hv[1] << 16); w.y = hv[2] | (hv[3] << 16); w.z = hv[4] | (hv[5] << 16); w.w = hv[6] | (hv[7] << 16); *(u32x4*)(sb + (d * 64 + 8 * j) * 2) = w; }
                { float kb[8];
#pragma unroll
                  for (int k = 0; k < 8; ++k) { const int t = 8 * j + k; kb[k] = __uint_as_float((unsigned)(*(const LAS unsigned short*)(colp + GP_ROW(t))) << 16) * (SM[64 + t] * SM[128 + t]); }
                  *(u32x4*)(sb + 16384 + (d * 64 + 8 * j) * 2) = pack8(kb); }
                { const int tb = 32 * (j >> 2) + 4 * (j & 3);
#pragma unroll
                  for (int k = 0; k < 8; ++k) hv[k] = *(const LAS unsigned short*)(colp + GP_KE + GP_ROW(tb + (k & 3) + 16 * (k >> 2)));
                  u32x4 w; w.x = hv[0] | (hv[1] << 16); w.y = hv[2] | (hv[3] << 16); w.z = hv[4] | (hv[5] << 16); w.w = hv[6] | (hv[7] << 16); *(u32x4*)(gb + GU_KDT + (d * 64 + 8 * j) * 2) = w; }
            }
        }
        {
            const int mt = wave & 3;
            int fr = lane & 15, fq = lane >> 4; asm volatile("" : "+v"(fr), "+v"(fq));
            if (wave < 4) {
#pragma unroll
                for (int nt = 0; nt < 4; ++nt) if (nt <= mt) {
                    f32x4 cacc = (f32x4){0.f, 0.f, 0.f, 0.f};
#pragma unroll
                    for (int sx = 0; sx < 4; ++sx) {
                        const bf16x8 A = *(const LAS bf16x8*)(YR + GP_ROW(16 * mt + fr) + (32 * sx + 8 * fq) * 2), B = *(const LAS bf16x8*)(YR + GP_ROW(16 * nt + fr) + (32 * sx + 8 * fq) * 2);
                        cacc = __builtin_amdgcn_mfma_f32_16x16x32_bf16(A, B, cacc, 0, 0, 0);
                    }
                    const int jj = 16 * nt + fr; const float cj = SM[jj];
#pragma unroll
                    for (int r = 0; r < 4; ++r) { const int i = 16 * mt + 4 * fq + r;
                        const float val = (i > jj) ? SM[64 + i] * cacc[r] * __expf(SM[i] - cj) : 0.f;
                        if (jj < ((i + 3) & ~3)) AM[uu * 2112 + tri_off(i) + jj] = val; }
                }
            } else {
#pragma unroll
                for (int jp = 0; jp < 2; ++jp) {
                    u32x2 half[2];
#pragma unroll
                    for (int jh = 0; jh < 2; ++jh) { const int jt = 2 * jp + jh;
                        f32x4 cacc = (f32x4){0.f, 0.f, 0.f, 0.f};
                        if (jt <= mt) {
#pragma unroll
                            for (int sx = 0; sx < 4; ++sx) {
                                const bf16x8 A = *(const LAS bf16x8*)(YR + GP_ROW(16 * jt + fr) + (32 * sx + 8 * fq) * 2), B = *(const LAS bf16x8*)(YR + GP_QN + GP_ROW(16 * mt + fr) + (32 * sx + 8 * fq) * 2);
                                cacc = __builtin_amdgcn_mfma_f32_16x16x32_bf16(A, B, cacc, 0, 0, 0);
                            }
                        }
                        const int i = 16 * mt + fr; const float ci = SM[i];
                        f32x4 o;
#pragma unroll
                        for (int r = 0; r < 4; ++r) { const int jj = 16 * jt + 4 * fq + r; o[r] = (i >= jj) ? cacc[r] * __expf(ci - SM[jj]) : 0.f; }
                        half[jh] = pack4(o); }
                    *(u32x4*)(gb + GU_QK + ((16 * mt + fr) * 64 + 32 * jp + 8 * fq) * 2) = (u32x4){half[0].x, half[0].y, half[1].x, half[1].y};
                }
            }
        }
    }
#undef GP_LOADROWS
    __syncthreads();
    {
        const LAS float* A = AM + wave * 2112;
        int lo = lane; asm volatile("" : "+v"(lo));
        float T[64];
#pragma unroll
        for (int i = 0; i < 64; ++i) {
            float acc = (lo == i) ? 1.f : 0.f;
#pragma unroll
            for (int j4 = 0; j4 < i; j4 += 4) {
                const f32x4 av = *(const LAS f32x4*)(A + tri_off(i) + j4);
                acc -= av[0] * T[j4];
                if (j4 + 1 < i) acc -= av[1] * T[j4 + 1];
                if (j4 + 2 < i) acc -= av[2] * T[j4 + 2];
                if (j4 + 3 < i) acc -= av[3] * T[j4 + 3];
            }
            T[i] = acc;
        }
        LAS unsigned short* Tb = (LAS unsigned short*)YR + wave * (64 * 72);
#pragma unroll
        for (int i = 0; i < 64; ++i) { const __bf16 hb = (__bf16)T[i]; Tb[i * 72 + lo] = __builtin_bit_cast(unsigned short, hb); }
    }
    asm volatile("" : "+v"(tid), "+v"(lane));
    const int frc = lane & 15, fqc = lane >> 4;
    u32x4 pv[4];
#define GP_LOADVK(u_) do { const unsigned char* _sb = SCR + (size_t)(u_) * 32768; int _t = tid; asm volatile("" : "+v"(_t)); \
        _Pragma("unroll") for (int q = 0; q < 4; ++q) { const int p = _t + q * NTHREADS, ts = p >> 10, pp = p & 1023, d = pp >> 3, ch = pp & 7; pv[q] = *(const u32x4*)(_sb + ts * 16384 + (d * 64 + ch * 8) * 2); } } while (0)
    GP_LOADVK(ug * 8);
#pragma unroll 1
    for (int uu = 0; uu < 8; ++uu) {
        const int u = ug * 8 + uu;
        unsigned char* gb = GDN + (size_t)u * GU_BYTES;
        __syncthreads();
#pragma unroll
        for (int q = 0; q < 4; ++q) { const int p = tid + q * NTHREADS, ts = p >> 10, pp = p & 1023, d = pp >> 3, ch = pp & 7; *(LAS u32x4*)(lds + ts * 18432 + d * 144 + ch * 16) = pv[q]; }
        { const int un = uu + 1 < 8 ? u + 1 : u; GP_LOADVK(un); }
        __syncthreads();
        const LAS unsigned char* Tu = YR + uu * 9216;
        {
            bf16x8 Vf[2];
#pragma unroll
            for (int sx = 0; sx < 2; ++sx) Vf[sx] = *(const LAS bf16x8*)(lds + ((16 * wave + frc) * 72 + 32 * sx + 8 * fqc) * 2);
#pragma unroll
            for (int mt = 0; mt < 4; ++mt) {
                f32x4 cu = (f32x4){0.f, 0.f, 0.f, 0.f};
#pragma unroll
                for (int sx = 0; sx < 2; ++sx) { const bf16x8 Tf = *(const LAS bf16x8*)(Tu + ((16 * mt + frc) * 72 + 32 * sx + 8 * fqc) * 2);
                    cu = __builtin_amdgcn_mfma_f32_16x16x32_bf16(Tf, Vf[sx], cu, 0, 0, 0); }
                *(u32x2*)(gb + GU_UT + ((16 * wave + frc) * 64 + 16 * mt + 4 * fqc) * 2) = pack4(cu);
            }
        }
        {
            const int wA = 2 * (wave >> 1), m0 = 2 * (wave & 1);
            bf16x8 KfA[2], KfB[2];
#pragma unroll
            for (int sx = 0; sx < 2; ++sx) { KfA[sx] = *(const LAS bf16x8*)(lds + 18432 + ((16 * wA + frc) * 72 + 32 * sx + 8 * fqc) * 2); KfB[sx] = *(const LAS bf16x8*)(lds + 18432 + ((16 * wA + 16 + frc) * 72 + 32 * sx + 8 * fqc) * 2); }
#pragma unroll
            for (int mx = 0; mx < 2; ++mx) {
                f32x4 ca = (f32x4){0.f, 0.f, 0.f, 0.f}, cb = (f32x4){0.f, 0.f, 0.f, 0.f};
#pragma unroll
                for (int sx = 0; sx < 2; ++sx) {
                    const bf16x8 T2 = *(const LAS bf16x8*)(Tu + ((16 * (m0 + mx) + frc) * 72 + 32 * sx + 8 * fqc) * 2);
                    ca = __builtin_amdgcn_mfma_f32_16x16x32_bf16(KfA[sx], T2, ca, 0, 0, 0);
                    cb = __builtin_amdgcn_mfma_f32_16x16x32_bf16(KfB[sx], T2, cb, 0, 0, 0);
                }
                const u32x2 pa = pack4(-ca), pb = pack4(-cb);
                *(u32x4*)(gb + GU_NW + ((16 * (m0 + mx) + frc) * 128 + 32 * (wave >> 1) + 8 * fqc) * 2) = (u32x4){pa.x, pa.y, pb.x, pb.y};
            }
        }
    }
#undef GP_LOADVK
}

__device__ __forceinline__ bf16x8 lda2(const LAS unsigned char* p) { const u32x2 a0 = *(const LAS u32x2*)p, a1 = *(const LAS u32x2*)(p + 32); u32x4 av; av.x = a0.x; av.y = a0.y; av.z = a1.x; av.w = a1.y; return __builtin_bit_cast(bf16x8, av); }
__device__ __forceinline__ bf16x8 packB(const f32x4 t0, const f32x4 t1) { u32x4 w; w.x = pk2(t0[0], t0[1]); w.y = pk2(t0[2], t0[3]); w.z = pk2(t1[0], t1[1]); w.w = pk2(t1[2], t1[3]); return __builtin_bit_cast(bf16x8, w); }

constexpr int SB_NW = 0, SB_QD = 17408, SB_KDT = 34816, SB_QK = 53248, SB_BYTES = 62464;
__device__ __forceinline__ float dpp_xor1(float v) { return __int_as_float(__builtin_amdgcn_update_dpp(0, __float_as_int(v), 0xB1, 0xF, 0xF, false)); }
__device__ __forceinline__ float dpp_xor2(float v) { return __int_as_float(__builtin_amdgcn_update_dpp(0, __float_as_int(v), 0x4E, 0xF, 0xF, false)); }
__device__ __forceinline__ float dpp_xor4(float v) { int t = __builtin_amdgcn_update_dpp(0, __float_as_int(v), 0x104, 0xF, 0x5, false);
    t = __builtin_amdgcn_update_dpp(t, __float_as_int(v), 0x114, 0xF, 0xA, false); return __int_as_float(t); }
__device__ __forceinline__ float dpp_xor8(float v) { return __int_as_float(__builtin_amdgcn_update_dpp(0, __float_as_int(v), 0x128, 0xF, 0xF, false)); }
__device__ __forceinline__ float tred16(const float (&v)[16], int fr) {
    float a[8], b[4], c[2];
#pragma unroll
    for (int i = 0; i < 8; ++i) { const bool up = (fr & 8) != 0; const float keep = up ? v[i + 8] : v[i], send = up ? v[i] : v[i + 8]; a[i] = keep + dpp_xor8(send); }
#pragma unroll
    for (int i = 0; i < 4; ++i) { const bool up = (fr & 4) != 0; const float keep = up ? a[i + 4] : a[i], send = up ? a[i] : a[i + 4]; b[i] = keep + dpp_xor4(send); }
#pragma unroll
    for (int i = 0; i < 2; ++i) { const bool up = (fr & 2) != 0; const float keep = up ? b[i + 2] : b[i], send = up ? b[i] : b[i + 2]; c[i] = keep + dpp_xor2(send); }
    const bool up = (fr & 1) != 0; const float keep = up ? c[1] : c[0], send = up ? c[0] : c[1];
    return keep + dpp_xor1(send);
}
__device__ __forceinline__ void gdn_scan(LAS unsigned char* lds, const unsigned char* GDN, const float* DECS, const bf16* HC, const float* normw, bf16* OAOB, float* SSQ, int bh, int half, int tid, int lane, int wave) {
    constexpr int SQ_OFF = 2 * SB_BYTES, OT_OFF = SQ_OFF + 2048, OT_STRIDE = 144, OT_BYTES = 64 * OT_STRIDE;
    LAS float* SQ = (LAS float*)(lds + SQ_OFF);
    LAS unsigned char* OT = lds + OT_OFF;
    LAS float* NWL = (LAS float*)(lds + OT_OFF + 2 * OT_BYTES);
    LAS float* DL = NWL + 64;
    const int fr = lane & 15, fq = lane >> 4, b = bh >> 3, h = bh & 7;
    if (tid < 64) { NWL[tid] = normw[64 * half + tid]; DL[tid] = DECS[bh * 64 + tid]; }
    const unsigned char* gbase = GDN + (size_t)bh * 64 * GU_BYTES;
    if (wave < 4) {
        const int cw = wave, dvl = 16 * cw + fr, dv = 64 * half + dvl;
        const int myrow = 16 * (fr >> 2) + 4 * fq + (fr & 3);
        const int uo = GU_UT + (dv * 64 + 4 * fq) * 2;
        u32x2 UA[4], UB[4];
#define SC_LOADU(cc, U) do { const unsigned char* _g = gbase + (size_t)(cc) * GU_BYTES + uo; _Pragma("unroll") for (int mt = 0; mt < 4; ++mt) U[mt] = *(const u32x2*)(_g + 32 * mt); } while (0)
        SC_LOADU(0, UA); SC_LOADU(1, UB);
        f32x4 S[8];
#pragma unroll
        for (int kt = 0; kt < 8; ++kt) S[kt] = (f32x4){0.f, 0.f, 0.f, 0.f};
        __syncthreads();
        auto cstep = [&](const int c, u32x2 (&U)[4]) __attribute__((always_inline)) {
            const int cur = c & 1;
            const LAS unsigned char* L = lds + cur * SB_BYTES;
            f32x4 vn[4], o[4];
#pragma unroll
            for (int mt = 0; mt < 4; ++mt) vn[mt] = (f32x4){bflo(U[mt].x), bfhi(U[mt].x), bflo(U[mt].y), bfhi(U[mt].y)};
            { const int c2 = c + 2 < 64 ? c + 2 : 63; SC_LOADU(c2, U); }
            const float cdec = DL[c];
            bf16x8 bS[4];
#pragma unroll
            for (int sx = 0; sx < 4; ++sx) bS[sx] = packB(S[2 * sx], S[2 * sx + 1]);
#define SC_FRAG(base, row, stride, sx) (*(const LAS bf16x8*)(L + (base) + (row) * (stride) + (32 * (sx) + 8 * fq) * 2))
#define SC_SB __builtin_amdgcn_sched_barrier(0)
            bf16x8 f0[8], f1[8];
            SC_SB;
#pragma unroll
            for (int q = 0; q < 8; ++q) f0[q] = SC_FRAG(SB_NW, 16 * (q >> 2) + fr, 272, q & 3);
            SC_SB;
#pragma unroll
            for (int q = 0; q < 8; ++q) f1[q] = SC_FRAG(SB_NW, 16 * (2 + (q >> 2)) + fr, 272, q & 3);
#pragma unroll
            for (int q = 0; q < 8; ++q) vn[q >> 2] = __builtin_amdgcn_mfma_f32_16x16x32_bf16(f0[q], bS[q & 3], vn[q >> 2], 0, 0, 0);
            SC_SB;
#pragma unroll
            for (int q = 0; q < 8; ++q) f0[q] = SC_FRAG(SB_QD, 16 * (q >> 2) + fr, 272, q & 3);
#pragma unroll
            for (int q = 0; q < 8; ++q) vn[2 + (q >> 2)] = __builtin_amdgcn_mfma_f32_16x16x32_bf16(f1[q], bS[q & 3], vn[2 + (q >> 2)], 0, 0, 0);
            SC_SB;
#pragma unroll
            for (int mt = 0; mt < 4; ++mt) o[mt] = (f32x4){0.f, 0.f, 0.f, 0.f};
#pragma unroll
            for (int q = 0; q < 8; ++q) f1[q] = SC_FRAG(SB_QD, 16 * (2 + (q >> 2)) + fr, 272, q & 3);
#pragma unroll
            for (int q = 0; q < 8; ++q) o[q >> 2] = __builtin_amdgcn_mfma_f32_16x16x32_bf16(f0[q], bS[q & 3], o[q >> 2], 0, 0, 0);
            SC_SB;
            bf16x8 bV[2];
            bV[0] = packB(vn[0], vn[1]); bV[1] = packB(vn[2], vn[3]);
#pragma unroll
            for (int q = 0; q < 8; ++q) f0[q] = SC_FRAG(SB_QK, 16 * (q >> 1) + fr, 144, q & 1);
#pragma unroll
            for (int q = 0; q < 8; ++q) o[2 + (q >> 2)] = __builtin_amdgcn_mfma_f32_16x16x32_bf16(f1[q], bS[q & 3], o[2 + (q >> 2)], 0, 0, 0);
            SC_SB;
#pragma unroll
            for (int q = 0; q < 8; ++q) f1[q] = SC_FRAG(SB_KDT, 16 * (q >> 1) + fr, 144, q & 1);
#pragma unroll
            for (int q = 0; q < 8; ++q) o[q >> 1] = __builtin_amdgcn_mfma_f32_16x16x32_bf16(f0[q], bV[q & 1], o[q >> 1], 0, 0, 0);
            SC_SB;
#pragma unroll
            for (int kt = 0; kt < 8; ++kt) S[kt] = S[kt] * cdec;
#pragma unroll
            for (int q = 0; q < 8; ++q) f0[q] = SC_FRAG(SB_KDT, 16 * (4 + (q >> 1)) + fr, 144, q & 1);
#pragma unroll
            for (int q = 0; q < 8; ++q) S[q >> 1] = __builtin_amdgcn_mfma_f32_16x16x32_bf16(f1[q], bV[q & 1], S[q >> 1], 0, 0, 0);
            SC_SB;
#pragma unroll
            for (int q = 0; q < 8; ++q) S[4 + (q >> 1)] = __builtin_amdgcn_mfma_f32_16x16x32_bf16(f0[q], bV[q & 1], S[4 + (q >> 1)], 0, 0, 0);
            SC_SB;
#undef SC_FRAG
#undef SC_SB
            float ssv[16];
            LAS unsigned short* ot = (LAS unsigned short*)(OT + cur * OT_BYTES + (4 * fq) * OT_STRIDE + dvl * 2);
#pragma unroll
            for (int mt = 0; mt < 4; ++mt)
#pragma unroll
                for (int r = 0; r < 4; ++r) { ssv[mt * 4 + r] = o[mt][r] * o[mt][r]; const __bf16 hb = (__bf16)o[mt][r]; ot[((16 * mt + r) * OT_STRIDE) / 2] = __builtin_bit_cast(unsigned short, hb); }
            SQ[cur * 256 + myrow * 4 + cw] = tred16(ssv, fr);
            asm volatile("s_waitcnt lgkmcnt(0)" ::: "memory"); __builtin_amdgcn_s_barrier(); asm volatile("" ::: "memory");
        };
#pragma unroll 1
        for (int c = 0; c < 64; c += 2) { cstep(c, UA); cstep(c + 1, UB); }
#undef SC_LOADU
    } else {
        const int t = tid - 256;
        const int r16 = t >> 4, c16 = t & 15, r8 = t >> 3, c8 = t & 7;
        const int go = t * 16;
        const int dA = r16 * 272 + c16 * 16, dB = r8 * 144 + c8 * 16;
        u32x4 X[14], Y[14], ZA[2], ZB[2];
#define SC_LOADX(cc, P) do { const unsigned char* _g = gbase + (size_t)(cc) * GU_BYTES + go; \
        _Pragma("unroll") for (int j = 0; j < 4; ++j) { P[j] = *(const u32x4*)(_g + GU_NW + 4096 * j); P[4 + j] = *(const u32x4*)(_g + GU_QD + 4096 * j); P[8 + j] = *(const u32x4*)(_g + GU_KDT + 4096 * j); } \
        P[12] = *(const u32x4*)(_g + GU_QK); P[13] = *(const u32x4*)(_g + GU_QK + 4096); } while (0)
#define SC_STOREX(bufsel, P) do { LAS unsigned char* _l = lds + (bufsel) * SB_BYTES; \
        _Pragma("unroll") for (int j = 0; j < 4; ++j) { *(LAS u32x4*)(_l + SB_NW + dA + 16 * 272 * j) = P[j]; *(LAS u32x4*)(_l + SB_QD + dA + 16 * 272 * j) = P[4 + j]; *(LAS u32x4*)(_l + SB_KDT + dB + 32 * 144 * j) = P[8 + j]; } \
        *(LAS u32x4*)(_l + SB_QK + dB) = P[12]; *(LAS u32x4*)(_l + SB_QK + dB + 32 * 144) = P[13]; } while (0)
#define SC_LOADZ(cc, Z) do { const bf16* _z = HC + ((size_t)b * SEQ + (size_t)(cc) * 64 + r8) * HC_W + 4608 + h * 128 + 64 * half + 8 * c8; Z[0] = *(const u32x4*)_z; Z[1] = *(const u32x4*)(_z + (size_t)32 * HC_W); } while (0)
        auto ostage = [&](const int cc, const u32x4 (&Z)[2]) __attribute__((always_inline)) {
            const int ob = cc & 1;
            const size_t tok0 = (size_t)b * SEQ + (size_t)cc * 64;
            const f32x4 nwa = *(const LAS f32x4*)(NWL + 8 * c8), nwb = *(const LAS f32x4*)(NWL + 8 * c8 + 4);
#pragma unroll
            for (int j = 0; j < 2; ++j) {
                const int row = r8 + 32 * j;
                const u32x4 ov = *(const LAS u32x4*)(OT + ob * OT_BYTES + row * OT_STRIDE + c8 * 16);
                const u32x4 zq = Z[j];
                float w8[8];
                w8[0] = bflo(ov.x) * bflo(zq.x) * nwa[0]; w8[1] = bfhi(ov.x) * bfhi(zq.x) * nwa[1]; w8[2] = bflo(ov.y) * bflo(zq.y) * nwa[2]; w8[3] = bfhi(ov.y) * bfhi(zq.y) * nwa[3];
                w8[4] = bflo(ov.z) * bflo(zq.z) * nwb[0]; w8[5] = bfhi(ov.z) * bfhi(zq.z) * nwb[1]; w8[6] = bflo(ov.w) * bflo(zq.w) * nwb[2]; w8[7] = bfhi(ov.w) * bfhi(zq.w) * nwb[3];
                *(u32x4*)(OAOB + (tok0 + row) * D + 1024 + h * 128 + 64 * half + 8 * c8) = pack8(w8);
                if (c8 == 0) { const f32x4 p0 = *(const LAS f32x4*)(SQ + ob * 256 + row * 4); SSQ[((size_t)half * MTOK + tok0 + row) * 8 + h] = (p0[0] + p0[1]) + (p0[2] + p0[3]); }
            }
        };
        SC_LOADX(0, X); SC_STOREX(0, X);
        SC_LOADX(1, X); SC_LOADX(2, Y);
        SC_LOADZ(0, ZA); SC_LOADZ(1, ZB);
        __syncthreads();
        SC_STOREX(1, X); SC_LOADX(3, X);
        asm volatile("s_waitcnt lgkmcnt(0)" ::: "memory"); __builtin_amdgcn_s_barrier(); asm volatile("" ::: "memory");
        auto sstep = [&](const int c, u32x4 (&P)[14], u32x4 (&Z)[2]) __attribute__((always_inline)) {
            SC_STOREX((c & 1) ^ 1, P);
            { const int c3 = c + 3 < 64 ? c + 3 : 63; SC_LOADX(c3, P); }
            ostage(c - 1, Z);
            { const int c1 = c + 1 < 64 ? c + 1 : 63; SC_LOADZ(c1, Z); }
            asm volatile("s_waitcnt lgkmcnt(0)" ::: "memory"); __builtin_amdgcn_s_barrier(); asm volatile("" ::: "memory");
        };
#pragma unroll 1
        for (int c = 1; c < 63; c += 2) { sstep(c, Y, ZA); sstep(c + 1, X, ZB); }
        sstep(63, Y, ZA);
        ostage(63, ZB);
#undef SC_LOADX
#undef SC_STOREX
#undef SC_LOADZ
    }
    __syncthreads();
}

__device__ __forceinline__ void moe_weight_items(LAS unsigned char* lds, const float* wgu, const float* wdn, bf16* WGU, bf16* WD, int w0, int nw, int lane, int wave, int begin = 0, int end = TI_MOE) {
    LAS float* scr = (LAS float*)(lds + wave * 16384);
    f32x4 va[8], vb[8];
    int it = begin + w0;
    if (it < end) { const TDesc d = moe_desc(it, wgu, wdn, WGU, WD); t_load(d, lane, va); }
    while (it < end) {
        const int nit = it + nw;
        if (nit < end) { const TDesc dn = moe_desc(nit, wgu, wdn, WGU, WD); t_load(dn, lane, vb); }
        { const TDesc d = moe_desc(it, wgu, wdn, WGU, WD); t_store(d, va, scr, lane); }
#pragma unroll
        for (int q = 0; q < 8; ++q) va[q] = vb[q];
        it = nit;
    }
}

__global__ void __launch_bounds__(NTHREADS, 2) fwd(Args a) {
    extern __shared__ __attribute__((aligned(16))) unsigned char lds_raw[];
    LAS unsigned char* lds = (LAS unsigned char*)lds_raw;
    const int wave = __builtin_amdgcn_readfirstlane((int)threadIdx.x >> 6);
    const int G = gridDim.x;
#define PHASE_IDS int lane = hw_lane(); asm volatile("" : "+v"(lane)); const int tid = wave * 64 + lane; const int gt = blockIdx.x * NTHREADS + tid; (void)lane; (void)gt
    volatile LAS unsigned* LCTL = (volatile LAS unsigned*)(lds + LDSCTL_OFF);
    { PHASE_IDS; for (int u = tid; u < 256; u += NTHREADS) LCTL[u] = 0u; }
    __syncthreads();
    unsigned char* ws = a.ws;
    unsigned* ctl = (unsigned*)(ws + WS_CTL);
    XcdBarrier bar = xcd_barrier_post(ctl + CW_BAR, LCTL + 8, wave == 0);

    const float* x = a.in[I_X];
#define MODP ((float*)(a.ws + WS_OAOB))
#define MOD ((float*)(a.ws + WS_MOD))
#define WRH ((bf16*)(a.ws + WS_WRH))
#define WRL ((bf16*)(a.ws + WS_WRL))
#define WGU ((bf16*)(a.ws + WS_WGU))
#define WD ((bf16*)(a.ws + WS_WD))
#define U ((bf16*)(a.ws + WS_U))
#define ULO ((bf16*)(a.ws + WS_ULO))
#define HB ((bf16*)(a.ws + WS_H))
#define YB ((bf16*)(a.ws + WS_Y))
#define TOKLIST ((int*)(a.ws + WS_TOKLIST))
#define RI ((i32x4*)(a.ws + WS_RI))
#define RW ((f32x2*)(a.ws + WS_RW))
#define CNT ((unsigned*)(a.ws + WS_CTL) + CW_CNT)
#define WIN ((bf16*)(a.ws + WS_WIN))
#define WP ((bf16*)(a.ws + WS_WP))
#define WOUT ((bf16*)(a.ws + WS_WOUT))
#define WBD ((float*)(a.ws + WS_WBD))
#define BETA ((float*)(a.ws + WS_BG))
#define GG (BETA + (size_t)MTOK * 8)
#define HC ((bf16*)(a.ws + WS_HCAT))
#define OAOB ((bf16*)(a.ws + WS_OAOB))
#define MERGED ((bf16*)(a.ws + WS_MERGED))
    const int gw = blockIdx.x * NWAVES + wave, NGW = G * NWAVES;
    const int NGT = G * NTHREADS;

    {
        PHASE_IDS;
        LAS float* scr = (LAS float*)(lds + wave * 16384);
        for (int it = gw; it < 192 * MOD_KS; it += NGW) p0_mod_item(a.in[I_C], a.in[I_WADA], MODP, it, lane);
        {
            f32x4 va[8], vb[8];
            const int p0_end = (((MTOK / 256) * (HC_W / 256)) % G != 0) ? TI_IN : TI_P0;
            int it = gw;
            if (it < p0_end) { const TDesc d = p0_desc(it, a.in[I_WIN], a.in[I_WPA], a.in[I_WPB], a.in[I_WOUT], WIN, WP, WOUT); t_load(d, lane, va); }
            while (it < p0_end) {
                const int nit = it + NGW;
                if (nit < p0_end) { const TDesc dn = p0_desc(nit, a.in[I_WIN], a.in[I_WPA], a.in[I_WPB], a.in[I_WOUT], WIN, WP, WOUT); t_load(dn, lane, vb); }
                { const TDesc d = p0_desc(it, a.in[I_WIN], a.in[I_WPA], a.in[I_WPB], a.in[I_WOUT], WIN, WP, WOUT); t_store(d, va, scr, lane); }
#pragma unroll
                for (int q = 0; q < 8; ++q) va[q] = vb[q];
                it = nit;
            }
        }
        for (int i = gt; i < 48 * D; i += NGT) { const int n = i / D, k = i - n * D;
            const float w = n < 32 ? a.in[I_WRE][(size_t)k * 32 + n] : (n < 36 ? a.in[I_WRG][(size_t)k * 4 + (n - 32)] : 0.f);
            const __bf16 hi = (__bf16)w; const float hf = (float)hi; const __bf16 lo = (__bf16)(w - hf);
            WRH[i] = __builtin_bit_cast(unsigned short, hi); WRL[i] = __builtin_bit_cast(unsigned short, lo); }
        for (int i = gt; i < 16 * D; i += NGT) { const int c = i / D, k = i - c * D; WBD[i] = a.in[I_WIN][(size_t)k * IN_W + 5632 + c]; }
    }
    xcd_barrier(bar);
    {
    PHASE_IDS;
    for (int i = gt; i < 4 * 6 * D; i += NGT) { const int n = i % (6 * D);
        MOD[i] = mod_sum(MODP, (size_t)i) + a.in[I_BADA][n]; }
    {
        LAS float* VEC = (LAS float*)lds;
        LAS float* WL = (LAS float*)(lds + 16384);
        for (int i = tid; i < 16 * D; i += NTHREADS) WL[i] = WBD[i];
        for (int grp = blockIdx.x; grp < MTOK / 64; grp += G) {
            const int b = (grp * 64) / SEQ;
            __syncthreads();
            for (int i = tid; i < 2 * D; i += NTHREADS) { const int n = i < D ? D + i : i - D; const size_t o = (size_t)b * 6 * D + n;
                const float v = mod_sum(MODP, o) + a.in[I_BADA][n];
                VEC[i] = i < D ? 1.f + v : v; }
            __syncthreads();
            const int mb = grp * 64 + wave * 8;
            f32x4 cur[2][8], nxt[2][8];
#pragma unroll
            for (int q = 0; q < 2; ++q) { const f32x4* xr = (const f32x4*)(x + (size_t)(mb + q) * D) + lane;
#pragma unroll
                for (int j = 0; j < 8; ++j) cur[q][j] = __builtin_nontemporal_load(xr + 64 * j); }
#pragma unroll 1
            for (int rr = 0; rr < 8; rr += 2) {
                const int mn = mb + (rr + 2 < 8 ? rr + 2 : rr);
#pragma unroll
                for (int q = 0; q < 2; ++q) { const f32x4* xr = (const f32x4*)(x + (size_t)(mn + q) * D) + lane;
#pragma unroll
                    for (int j = 0; j < 8; ++j) nxt[q][j] = __builtin_nontemporal_load(xr + 64 * j); }
                ln_norm(cur[0], lane); ln_norm(cur[1], lane);
#pragma unroll
                for (int j = 0; j < 8; ++j) { const f32x4 sc = *(const LAS f32x4*)(VEC + 4 * lane + 256 * j), sh = *(const LAS f32x4*)(VEC + D + 4 * lane + 256 * j);
#pragma unroll
                    for (int q = 0; q < 2; ++q) { cur[q][j] = cur[q][j] * sc + sh;
                        ((unsigned*)((unsigned char*)U + (size_t)(mb + rr + q) * D) + lane)[64 * j] = pk_fp8x4(cur[q][j][0], cur[q][j][1], cur[q][j][2], cur[q][j][3]); } }
                float mine0 = 0.f, mine1 = 0.f;
#pragma unroll 1
                for (int c = 0; c < 16; ++c) { float a0 = 0.f, a1 = 0.f;
                    asm volatile("" ::: "memory");
#pragma unroll
                    for (int j = 0; j < 8; ++j) { const f32x4 w = *(const LAS f32x4*)(WL + c * D + 4 * lane + 256 * j);
                        a0 += (cur[0][j][0] * w[0] + cur[0][j][1] * w[1]) + (cur[0][j][2] * w[2] + cur[0][j][3] * w[3]);
                        a1 += (cur[1][j][0] * w[0] + cur[1][j][1] * w[1]) + (cur[1][j][2] * w[2] + cur[1][j][3] * w[3]); }
#pragma unroll
                    for (int o = 1; o < 64; o <<= 1) { a0 += shx(a0, o, lane); a1 += shx(a1, o, lane); }
                    mine0 = (lane == c) ? a0 : mine0; mine1 = (lane == c) ? a1 : mine1; }
#pragma unroll
                for (int q = 0; q < 2; ++q) { const float mine = q ? mine1 : mine0; const size_t m = (size_t)(mb + rr + q);
                    if (lane < 8) BETA[m * 8 + lane] = sigmoidf_(mine);
                    else if (lane < 16) { const int hh = lane - 8; const float z = mine + a.in[I_DTB][hh]; const float sp = z > 20.f ? z : log1pf(__expf(z)); GG[m * 8 + hh] = -__expf(a.in[I_ALOG][hh]) * sp; } }
#pragma unroll
                for (int q = 0; q < 2; ++q)
#pragma unroll
                    for (int j = 0; j < 8; ++j) cur[q][j] = nxt[q][j];
            }
        }
    }
    }
    xcd_barrier(bar);
    {
        pg8::StaticOrder S; S.init(U, WIN, MTOK, HC_W, D / 2, G, blockIdx.x);
        pg8::EpiHcat E{HC, 1.f / 64.f};
        { const int nwg = (MTOK / 256) * (HC_W / 256), first = nwg % G;
          if (first != 0 && (int)blockIdx.x >= first) { const int pop = ((int)blockIdx.x - first) * 3 / (G - first);
              {
                  PHASE_IDS;
                  LAS float* scr = (LAS float*)(lds + wave * 16384);
                  f32x4 va[8], vb[8];
                  const int nw2 = (G - first) * NWAVES;
                  int it = TI_IN + ((int)blockIdx.x - first) * NWAVES + wave;
                  if (it < TI_P0) { const TDesc d = p0_desc(it, a.in[I_WIN], a.in[I_WPA], a.in[I_WPB], a.in[I_WOUT], WIN, WP, WOUT); t_load(d, lane, va); }
                  while (it < TI_P0) {
                      const int nit = it + nw2;
                      if (nit < TI_P0) { const TDesc dn = p0_desc(nit, a.in[I_WIN], a.in[I_WPA], a.in[I_WPB], a.in[I_WOUT], WIN, WP, WOUT); t_load(dn, lane, vb); }
                      { const TDesc d = p0_desc(it, a.in[I_WIN], a.in[I_WPA], a.in[I_WPB], a.in[I_WOUT], WIN, WP, WOUT); t_store(d, va, scr, lane); }
#pragma unroll
                      for (int q = 0; q < 8; ++q) va[q] = vb[q];
                      it = nit;
                  }
                  __syncthreads();
                  moe_weight_items(lds, a.in[I_WGU], a.in[I_WDN], WGU, WD, ((int)blockIdx.x - first) * NWAVES + wave, nw2, lane, wave, 0, TI_EARLY);
                  __syncthreads();
              }
              for (int i = 0; i < pop; ++i) __builtin_amdgcn_s_sleep(100); } }
        pg8::gemm_phase<pg8::EpiHcat, pg8::StaticOrder, false, false, true>(lds, S, E, wave);
    }
    xcd_barrier(bar);
    {
        PHASE_IDS;
        float* DECS = BETA + (size_t)MTOK * 16;
        for (int ug = blockIdx.x; ug < 256; ug += G) gdn_pre(lds, HC, a.in[I_CONVW], BETA, GG, ws + WS_GDN, ws + WS_MERGED, DECS, ug, tid, lane, wave);
    }
    xcd_barrier(bar);
    {
        PHASE_IDS;
        const float* DECS = BETA + (size_t)MTOK * 16;
        float* SSQ = (float*)(ws + WS_MODP);
        const int nsc = G > 128 ? 64 : 0;
        if (nsc) {
            if ((int)blockIdx.x < nsc) gdn_scan(lds, ws + WS_GDN, DECS, HC, a.in[I_NORMW], OAOB, SSQ, blockIdx.x >> 1, blockIdx.x & 1, tid, lane, wave);
            else {
                for (int unit = blockIdx.x - nsc; unit < BATCH * 64 * 4; unit += G - nsc) swa_unit(lds, HC, (bf16*)(ws + WS_U + 32 * MiB), a.in[I_SINKS], unit, tid, lane, wave);
                __syncthreads();
                moe_weight_items(lds, a.in[I_WGU], a.in[I_WDN], WGU, WD, (blockIdx.x - nsc) * NWAVES + wave, (G - nsc) * NWAVES, lane, wave, ((((MTOK / 256) * (HC_W / 256)) % G != 0) ? TI_EARLY : 0));
            }
        } else {
            for (int w = blockIdx.x; w < 64; w += G) gdn_scan(lds, ws + WS_GDN, DECS, HC, a.in[I_NORMW], OAOB, SSQ, w >> 1, w & 1, tid, lane, wave);
            for (int unit = blockIdx.x; unit < BATCH * 64 * 4; unit += G) swa_unit(lds, HC, (bf16*)(ws + WS_U + 32 * MiB), a.in[I_SINKS], unit, tid, lane, wave);
            __syncthreads();
            moe_weight_items(lds, a.in[I_WGU], a.in[I_WDN], WGU, WD, blockIdx.x * NWAVES + wave, G * NWAVES, lane, wave, ((((MTOK / 256) * (HC_W / 256)) % G != 0) ? TI_EARLY : 0));
        }
    }
    xcd_barrier(bar);
    {
        PHASE_IDS;
        const float* SSQ = (const float*)(ws + WS_MODP);
        unsigned char* OAOB8 = ws + WS_U + 32 * MiB;
        const int gw2 = blockIdx.x * NWAVES + wave;
        for (int m = gw2; m < MTOK; m += G * NWAVES) {
            const int hh = lane >> 3;
            const float rstd = rsqrtf((SSQ[(size_t)m * 8 + hh] + SSQ[((size_t)MTOK + m) * 8 + hh]) * (1.f / 128.f) + 1e-6f);
            const u32x4* pp = (const u32x4*)(OAOB + (size_t)m * D + 1024 + 16 * lane);
            const u32x4 v0 = pp[0], v1 = pp[1];
            const float r4 = fminf(4.f * rstd, 3.0e38f);
#define P4B_C(x) fminf(fmaxf((x) * r4, -440.f), 440.f)
            u32x4 w;
            w.x = pk_fp8x4(P4B_C(bflo(v0.x)), P4B_C(bfhi(v0.x)), P4B_C(bflo(v0.y)), P4B_C(bfhi(v0.y))); w.y = pk_fp8x4(P4B_C(bflo(v0.z)), P4B_C(bfhi(v0.z)), P4B_C(bflo(v0.w)), P4B_C(bfhi(v0.w)));
            w.z = pk_fp8x4(P4B_C(bflo(v1.x)), P4B_C(bfhi(v1.x)), P4B_C(bflo(v1.y)), P4B_C(bfhi(v1.y))); w.w = pk_fp8x4(P4B_C(bflo(v1.z)), P4B_C(bfhi(v1.z)), P4B_C(bflo(v1.w)), P4B_C(bfhi(v1.w)));
#undef P4B_C
            *(u32x4*)(OAOB8 + (size_t)m * D + 1024 + 16 * lane) = w;
        }
    }
    xcd_barrier(bar);
    {
        pg8::StaticOrder S; S.init(ws + WS_U + 32 * MiB, WP, MTOK, D, D / 2, G, blockIdx.x, 8);
        pg8::EpiMerged E{HC, MERGED};
        pg8::gemm_phase<pg8::EpiMerged, pg8::StaticOrder, false, true, true>(lds, S, E, wave);
    }
    xcd_barrier(bar);
    {
        pg8::StaticOrder S; S.init(MERGED, WOUT, MTOK, D, D / 2, G, blockIdx.x, 8);
        pg8::EpiMixG E{MOD, OAOB, 1.f / 2048.f};
        pg8::gemm_phase<pg8::EpiMixG, pg8::StaticOrder, false, false, true>(lds, S, E, wave);
    }
    xcd_barrier(bar);

    {
        PHASE_IDS;
        LAS float* VEC = (LAS float*)lds;
        LAS float* PART = (LAS float*)(lds + 32768);
        LAS float* LOGIT = (LAS float*)(lds + 32768 + 98304);
        LAS int* CNTL = (LAS int*)(lds + 32768 + 98304 + 12288);
        for (int grp = blockIdx.x; grp < MTOK / 64; grp += G) {
            const int b = (grp * 64) / SEQ;
            const int r0 = grp * 64 + wave * 8;
            {
                f32x4 cur[8], nx[8]; u32x2 nm[8];
#define P7_LOADROW(m_) do { const f32x4* _xr = (const f32x4*)(x + (size_t)(m_) * D) + lane; const u32x2* _mr = (const u32x2*)(OAOB + (size_t)(m_) * D) + lane; \
                    _Pragma("unroll") for (int j = 0; j < 8; ++j) { nx[j] = __builtin_nontemporal_load(_xr + 64 * j); nm[j] = _mr[64 * j]; } } while (0)
#define P7_TAKEROW() do { _Pragma("unroll") for (int j = 0; j < 8; ++j) cur[j] = nx[j] * ALPHA + (f32x4){bflo(nm[j].x), bfhi(nm[j].x), bflo(nm[j].y), bfhi(nm[j].y)}; } while (0)
                P7_LOADROW(r0);
                __syncthreads();
                for (int i = tid; i < D; i += NTHREADS) { VEC[i] = a.in[I_LN1G][i]; VEC[D + i] = a.in[I_LN1B][i]; VEC[2 * D + i] = 1.f + MOD[(size_t)b * 6 * D + 4 * D + i]; VEC[3 * D + i] = MOD[(size_t)b * 6 * D + 3 * D + i]; }
                __syncthreads();
                P7_TAKEROW();
#pragma unroll 1
                for (int rr = 0; rr < 8; ++rr) {
                    const int m = r0 + rr;
                    P7_LOADROW((rr + 1 < 8 ? m + 1 : m));
                    asm volatile("" ::: "memory");
                    u32x2* o = (u32x2*)((bf16*)(a.ws + WS_GDN) + (size_t)m * D) + lane;
                    ln_norm(cur, lane);
#pragma unroll
                    for (int j = 0; j < 8; ++j) { const f32x4 gg = *(const LAS f32x4*)(VEC + 4 * lane + 256 * j), bb = *(const LAS f32x4*)(VEC + D + 4 * lane + 256 * j); cur[j] = cur[j] * gg + bb; u32x2 w1; w1.x = pk2(cur[j][0], cur[j][1]); w1.y = pk2(cur[j][2], cur[j][3]); o[64 * j] = w1; }
                    ln_norm(cur, lane);
                    u32x2* ul = (u32x2*)(ULO + (size_t)m * D) + lane;
#pragma unroll
                    for (int j = 0; j < 8; ++j) { const f32x4 sc = *(const LAS f32x4*)(VEC + 2 * D + 4 * lane + 256 * j), sh = *(const LAS f32x4*)(VEC + 3 * D + 4 * lane + 256 * j);
                        const f32x4 t = cur[j] * sc + sh;
                        const unsigned p8 = pk_fp8x4(t[0], t[1], t[2], t[3]);
                        const f32x2 d0 = __builtin_amdgcn_cvt_pk_f32_fp8(p8, false), d1 = __builtin_amdgcn_cvt_pk_f32_fp8(p8, true);
                        u32x2 l; l.x = pk2(t[0] - d0[0], t[1] - d0[1]); l.y = pk2(t[2] - d1[0], t[3] - d1[1]);
                        ul[64 * j] = l; ((unsigned*)(a.ws + WS_MERGED + (size_t)m * D) + lane)[64 * j] = p8; }
                    P7_TAKEROW();
                }
            }
#undef P7_TAKEROW
#undef P7_LOADROW
            VM_WAIT();
            __syncthreads();
            {
                const int fr = lane & 15, fq = lane >> 4;
                f32x4 cacc[4][3];
#pragma unroll
                for (int mt = 0; mt < 4; ++mt)
#pragma unroll
                    for (int nt = 0; nt < 3; ++nt) cacc[mt][nt] = (f32x4){0.f, 0.f, 0.f, 0.f};
                const size_t g0 = (size_t)grp * 64;
                const unsigned char* a8 = a.ws + WS_MERGED + (g0 + fr) * D + 256 * wave + 8 * fq; const bf16* al = ULO + (g0 + fr) * D + 256 * wave + 8 * fq;
                const bf16* bh = WRH + (size_t)fr * D + 256 * wave + 8 * fq; const bf16* bl = WRL + (size_t)fr * D + 256 * wave + 8 * fq;
#pragma unroll 2
                for (int sx = 0; sx < 8; ++sx) {
                    bf16x8 Ah[4], Al[4], Bh[3], Bl[3];
#pragma unroll
                    for (int mt = 0; mt < 4; ++mt) { const u32x2 q8 = *(const u32x2*)(a8 + (size_t)mt * 16 * D + 32 * sx);
                        const f32x2 e0 = __builtin_amdgcn_cvt_pk_f32_fp8(q8.x, false), e1 = __builtin_amdgcn_cvt_pk_f32_fp8(q8.x, true), e2 = __builtin_amdgcn_cvt_pk_f32_fp8(q8.y, false), e3 = __builtin_amdgcn_cvt_pk_f32_fp8(q8.y, true);
                        u32x4 hw; hw.x = pk2(e0[0], e0[1]); hw.y = pk2(e1[0], e1[1]); hw.z = pk2(e2[0], e2[1]); hw.w = pk2(e3[0], e3[1]);
                        Ah[mt] = __builtin_bit_cast(bf16x8, hw); Al[mt] = *(const bf16x8*)(al + (size_t)mt * 16 * D + 32 * sx); }
#pragma unroll
                    for (int nt = 0; nt < 3; ++nt) { Bh[nt] = *(const bf16x8*)(bh + (size_t)nt * 16 * D + 32 * sx); Bl[nt] = *(const bf16x8*)(bl + (size_t)nt * 16 * D + 32 * sx); }
#pragma unroll
                    for (int mt = 0; mt < 4; ++mt)
#pragma unroll
                        for (int nt = 0; nt < 3; ++nt) {
                            cacc[mt][nt] = __builtin_amdgcn_mfma_f32_16x16x32_bf16(Ah[mt], Bh[nt], cacc[mt][nt], 0, 0, 0);
                            cacc[mt][nt] = __builtin_amdgcn_mfma_f32_16x16x32_bf16(Al[mt], Bh[nt], cacc[mt][nt], 0, 0, 0);
                            cacc[mt][nt] = __builtin_amdgcn_mfma_f32_16x16x32_bf16(Ah[mt], Bl[nt], cacc[mt][nt], 0, 0, 0);
                        }
                }
#pragma unroll
                for (int mt = 0; mt < 4; ++mt)
#pragma unroll
                    for (int nt = 0; nt < 3; ++nt)
#pragma unroll
                        for (int jx = 0; jx < 4; ++jx) PART[(wave * 64 + 16 * mt + 4 * fq + jx) * 48 + 16 * nt + fr] = cacc[mt][nt][jx];
            }
            if (tid < 64) CNTL[tid] = 0;
            __syncthreads();
            for (int idx = tid; idx < 64 * 48; idx += NTHREADS) { float sacc = 0.f;
#pragma unroll
                for (int w8 = 0; w8 < 8; ++w8) sacc += PART[w8 * 64 * 48 + idx];
                LOGIT[idx] = sacc; }
            __syncthreads();
            int e0 = 0, e1 = 0, rk0 = 0, rk1 = 0; float w0 = 0.f, w1 = 0.f;
            if (tid < 64) {
                const LAS float* lg = LOGIT + tid * 48;
                float gl[4]; float gmax = -3.0e38f; int gi = 0;
#pragma unroll
                for (int jx = 0; jx < 4; ++jx) { gl[jx] = lg[32 + jx] + a.in[I_BRG][jx]; if (gl[jx] > gmax) { gmax = gl[jx]; gi = jx; } }
                float gs = 0.f;
#pragma unroll
                for (int jx = 0; jx < 4; ++jx) gs += __expf(gl[jx] - gmax);
                const float pg = 1.f / gs;
                float el[8]; float emax = -3.0e38f; int i0 = 0;
#pragma unroll
                for (int jx = 0; jx < 8; ++jx) { el[jx] = lg[8 * gi + jx] + a.in[I_BRE][8 * gi + jx]; if (el[jx] > emax) { emax = el[jx]; i0 = jx; } }
                float e2 = -3.0e38f; int i1 = 0;
#pragma unroll
                for (int jx = 0; jx < 8; ++jx) { if (jx != i0 && el[jx] > e2) { e2 = el[jx]; i1 = jx; } }
                const float p1r = __expf(e2 - emax);
                const float t0 = 1.f / (1.f + p1r), t1 = p1r * t0;
                e0 = 8 * gi + i0; e1 = 8 * gi + i1; w0 = pg * t0; w1 = pg * t1;
                rk0 = __hip_atomic_fetch_add(CNTL + e0, 1, __ATOMIC_RELAXED, __HIP_MEMORY_SCOPE_WORKGROUP);
                rk1 = __hip_atomic_fetch_add(CNTL + e1, 1, __ATOMIC_RELAXED, __HIP_MEMORY_SCOPE_WORKGROUP);
            }
            __syncthreads();
            if (tid < 32) { const int cn = CNTL[tid]; CNTL[32 + tid] = cn ? (int)atomicAdd(CNT + 64 * tid, (unsigned)cn) : 0; }
            __syncthreads();
            if (tid < 64) {
                const int m = grp * 64 + tid, pos0 = CNTL[32 + e0] + rk0, pos1 = CNTL[32 + e1] + rk1;
                TOKLIST[(size_t)e0 * MTOK + pos0] = m; TOKLIST[(size_t)e1 * MTOK + pos1] = m;
                RI[m] = (i32x4){e0, pos0, e1, pos1}; RW[m] = (f32x2){w0, w1};
            }
        }
    }
    xcd_barrier(bar);

    volatile LAS int* TB = (volatile LAS int*)(LCTL + 16);
    if (wave == 0 && hw_lane() == 0) { int acc = 0; for (int e = 0; e < NEXP; ++e) { const int c = (int)__hip_atomic_load(CNT + 64 * e, __ATOMIC_RELAXED, __HIP_MEMORY_SCOPE_AGENT); TB[e] = acc; TB[33 + e] = c; acc += (c + 255) >> 8; } TB[32] = acc; }
    __syncthreads();

    {
        pg8::MoeOrder S; S.A = (const char*)(a.ws + WS_MERGED); S.Bt = (const char*)WGU; S.K = D / 2; S.b_estride = (size_t)1024 * D; S.toklist = TOKLIST; S.tb = TB; S.ncol = 4; S.G = G; S.c = blockIdx.x; S.ready = nullptr; S.need = 0u; S.heavy = 0;
        pg8::EpiGateUp E{HB, 1.f / 64.f, ctl + CW_RT};
        pg8::gemm_phase<pg8::EpiGateUp, pg8::MoeOrder, true, false, true>(lds, S, E, wave);
    }
    {
        pg8::MoeOrder S; S.A = (const char*)HB; S.Bt = (const char*)WD; S.K = EFF / 2; S.b_estride = (size_t)D * EFF; S.toklist = nullptr; S.tb = TB; S.ncol = 8; S.G = G; S.c = blockIdx.x; S.ready = ctl + CW_RT; S.need = 32u; { const int r8 = (TB[32] * 4) % G; S.heavy = r8 ? ((r8 + 7) & ~7) : 0; if (S.heavy >= G) S.heavy = 0; }
        pg8::EpiBf16 E{(unsigned char*)YB, D, 64.f / 512.f};
        pg8::gemm_phase<pg8::EpiBf16, pg8::MoeOrder, false, false, true>(lds, S, E, wave);
    }
    xcd_barrier(bar);
    {
        PHASE_IDS;
        LAS float* VEC = (LAS float*)lds;
        for (int grp = blockIdx.x; grp < MTOK / 64; grp += G) {
            const int b = (grp * 64) / SEQ;
            {
                const int mb = grp * 64 + wave * 8;
#define P10_ISSUE(ri_, m_, X_, Y0_, Y1_) do { const int _s0 = 256 * TB[(ri_).x] + (ri_).y, _s1 = 256 * TB[(ri_).z] + (ri_).w; \
                    const u32x2* _o = (const u32x2*)((const bf16*)(a.ws + WS_GDN) + (size_t)(m_) * D) + lane; const unsigned* _y0 = (const unsigned*)((const unsigned char*)YB + (size_t)_s0 * D) + lane; const unsigned* _y1 = (const unsigned*)((const unsigned char*)YB + (size_t)_s1 * D) + lane; \
                    _Pragma("unroll") for (int j = 0; j < 8; ++j) { X_[j] = _o[64 * j]; Y0_[j] = _y0[64 * j]; Y1_[j] = _y1[64 * j]; } } while (0)
                i32x4 riB = RI[mb + 1], riC; f32x2 rwA = RW[mb], rwB = RW[mb + 1], rwC;
                u32x2 cx[8], nx[8]; unsigned cy0[8], cy1[8], ny0[8], ny1[8];
                { const i32x4 riA = RI[mb]; P10_ISSUE(riA, mb, cx, cy0, cy1); }
                __syncthreads();
                for (int i = tid; i < D; i += NTHREADS) { VEC[i] = a.in[I_LN2G][i]; VEC[D + i] = a.in[I_LN2B][i]; VEC[2 * D + i] = MOD[(size_t)b * 6 * D + 5 * D + i]; }
                __syncthreads();
#pragma unroll 1
                for (int rr = 0; rr < 8; ++rr) {
                    const int m = mb + rr, m1 = mb + (rr + 1 < 8 ? rr + 1 : 7), m2 = mb + (rr + 2 < 8 ? rr + 2 : 7);
                    riC = RI[m2]; rwC = RW[m2];
                    P10_ISSUE(riB, m1, nx, ny0, ny1);
                    asm volatile("" ::: "memory");
                    f32x4 v[8];
#pragma unroll
                    for (int j = 0; j < 8; ++j) {
                        const f32x2 p0 = __builtin_amdgcn_cvt_pk_f32_fp8(cy0[j], false), p1 = __builtin_amdgcn_cvt_pk_f32_fp8(cy0[j], true), q0 = __builtin_amdgcn_cvt_pk_f32_fp8(cy1[j], false), q1 = __builtin_amdgcn_cvt_pk_f32_fp8(cy1[j], true);
                        const float w0 = rwA.x * (1.f / 64.f), w1 = rwA.y * (1.f / 64.f);
                        const f32x4 f = {w0 * p0[0] + w1 * q0[0], w0 * p0[1] + w1 * q0[1], w0 * p1[0] + w1 * q1[0], w0 * p1[1] + w1 * q1[1]};
                        const f32x4 g2 = *(const LAS f32x4*)(VEC + 2 * D + 4 * lane + 256 * j);
                        v[j] = (f32x4){bflo(cx[j].x), bfhi(cx[j].x), bflo(cx[j].y), bfhi(cx[j].y)} * ALPHA + g2 * f;
                    }
                    ln_norm(v, lane);
                    f32x4* o = (f32x4*)(a.out + (size_t)m * D) + lane;
#pragma unroll
                    for (int j = 0; j < 8; ++j) { const f32x4 gg = *(const LAS f32x4*)(VEC + 4 * lane + 256 * j), bb = *(const LAS f32x4*)(VEC + D + 4 * lane + 256 * j); o[64 * j] = v[j] * gg + bb; }
#pragma unroll
                    for (int j = 0; j < 8; ++j) { cx[j] = nx[j]; cy0[j] = ny0[j]; cy1[j] = ny1[j]; }
                    rwA = rwB; riB = riC; rwB = rwC;
                }
#undef P10_ISSUE
            }
        }
    }
}

#undef MODP
#undef MOD
#undef WRH
#undef WRL
#undef WGU
#undef WD
#undef U
#undef ULO
#undef HB
#undef YB
#undef TOKLIST
#undef RI
#undef RW
#undef CNT
#undef WIN
#undef WP
#undef WOUT
#undef WBD
#undef BETA
#undef GG
#undef HC
#undef OAOB
#undef MERGED

extern "C" void kernel_launch(void* const* d_in, const int* in_sizes, int n_in, void* d_out, int out_size, void* d_ws, size_t ws_size, hipStream_t stream) {
    static int grid = 0;
    if (grid == 0) {
        int dev = 0, cus = 0, per_cu = 0;
        if (n_in != 23 || out_size != MTOK * D || ws_size < WS_END) { fprintf(stderr, "kernel_launch: unexpected shapes (n_in %d out %d ws %zu)\n", n_in, out_size, ws_size); grid = -1; return; }
        if (hipGetDevice(&dev) != hipSuccess || hipDeviceGetAttribute(&cus, hipDeviceAttributeMultiprocessorCount, dev) != hipSuccess) { grid = -1; return; }
        if (hipFuncSetAttribute((const void*)fwd, hipFuncAttributeMaxDynamicSharedMemorySize, LDS_BYTES) != hipSuccess) { fprintf(stderr, "hipFuncSetAttribute failed\n"); grid = -1; return; }
        if (hipOccupancyMaxActiveBlocksPerMultiprocessor(&per_cu, (const void*)fwd, NTHREADS, LDS_BYTES) != hipSuccess || per_cu < 1) fprintf(stderr, "occupancy query says %d\n", per_cu);
        (void)hipGetLastError();
        grid = cus;
    }
    if (grid < 0) return;
    (void)hipMemsetAsync((char*)d_ws + WS_CTL, 0, CTL_ZERO_BYTES, stream);
    Args a{};
    for (int i = 0; i < 23; ++i) a.in[i] = (const float*)d_in[i];
    a.out = (float*)d_out; a.ws = (unsigned char*)d_ws;
    hipLaunchKernelGGL(fwd, dim3(grid), dim3(NTHREADS), LDS_BYTES, stream, a);
}
```
